# Optimizing an MI355X kernel written in HIP

```python
import jax, jax.numpy as jnp
from jax import lax
import numpy as np

D_MODEL = 1024
BATCH = 4
SEQ = 4096
DEPTH = 4
DEC_BATCH = 128
DEC_SEQ = 4
PAST_LEN = 8192
PAGE_SIZE = 128

WINDOW = 128
N_HEADS = 8
KV_HEADS = 2
HEAD_DIM = 64
Q_PER_KV = N_HEADS // KV_HEADS
ATT_WIDTH = N_HEADS * HEAD_DIM
HG_HEADS = 4
HG_DK = 128
HG_DV = 128
HG_KEY_WIDTH = HG_HEADS * HG_DK
HG_VAL_WIDTH = HG_HEADS * HG_DV
HG_CHUNK = 64
D_FF = 4 * D_MODEL
N_BRANCH = 2
SPLIT_SIZES = (ATT_WIDTH, KV_HEADS * HEAD_DIM, KV_HEADS * HEAD_DIM,
               HG_KEY_WIDTH, HG_KEY_WIDTH, HG_VAL_WIDTH, HG_VAL_WIDTH, N_BRANCH * D_MODEL)
IN_COLS = sum(SPLIT_SIZES)
DEEPNORM_ALPHA = (2 * DEPTH) ** 0.25
DEEPNORM_BETA = (8 * DEPTH) ** -0.25
LN_EPS = 1e-5
RMS_EPS = 1e-6
NEG_BIG = -1e30
LB_FLOOR = 1e-30

kernel_name = "hybrid_swa_sink_hgrn2_deepnorm_step"


def _layer_norm(x, g, b):
    xf = x.astype(jnp.float32)
    mu = xf.mean(-1, keepdims=True)
    var = jnp.square(xf - mu).mean(-1, keepdims=True)
    y = (xf - mu) * lax.rsqrt(var + LN_EPS) * g.astype(jnp.float32) + b.astype(jnp.float32)
    return y.astype(x.dtype)


def _rms_norm(x, g):
    xf = x.astype(jnp.float32)
    return xf * lax.rsqrt(jnp.mean(jnp.square(xf), -1, keepdims=True) + RMS_EPS) * g.astype(jnp.float32)


def _sink_attention(q, k, v, mask, sink):
    s = jnp.einsum('...qkgd,...jkd->...kgqj', q.astype(jnp.float32), k.astype(jnp.float32)) * (HEAD_DIM ** -0.5)
    s = jnp.where(mask, s, NEG_BIG)
    snk = jnp.broadcast_to(sink.astype(jnp.float32).reshape(KV_HEADS, Q_PER_KV, 1, 1), s.shape[:-1] + (1,))
    p = jax.nn.softmax(jnp.concatenate([s, snk], axis=-1), axis=-1)[..., :-1]
    return jnp.einsum('...kgqj,...jkd->...qkgd', p, v.astype(jnp.float32))


def _window_attn_prompt(q, k, v, sink):
    B, S = q.shape[:2]
    nb = S // WINDOW
    qb = q.reshape(B, nb, WINDOW, KV_HEADS, Q_PER_KV, HEAD_DIM)

    def with_prev(t):
        t = t.reshape(B, nb, WINDOW, KV_HEADS, HEAD_DIM)
        prev = jnp.pad(t, ((0, 0), (1, 0), (0, 0), (0, 0), (0, 0)))[:, :-1]
        return jnp.concatenate([prev, t], axis=2)

    blk = jnp.arange(nb)[:, None, None]
    qi = jnp.arange(WINDOW)[None, :, None]
    kj = jnp.arange(2 * WINDOW)[None, None, :]
    diff = WINDOW + qi - kj
    kpos = (blk - 1) * WINDOW + kj
    mask = (diff >= 0) & (diff <= WINDOW) & (kpos >= 0)
    o = _sink_attention(qb, with_prev(k), with_prev(v), mask[None, :, None, None], sink)
    return o.reshape(B, S, ATT_WIDTH)


def _window_attn_sample(q, k_new, v_new, k_cache, v_cache, sink):
    B, T = q.shape[:2]
    W = k_cache.shape[1]
    kk = jnp.concatenate([k_cache.astype(k_new.dtype), k_new], axis=1)
    vv = jnp.concatenate([v_cache.astype(v_new.dtype), v_new], axis=1)
    qi = jnp.arange(T)[:, None]
    kj = jnp.arange(W + T)[None, :]
    diff = W + qi - kj
    mask = (diff >= 0) & (diff <= WINDOW)
    o = _sink_attention(q, kk, vv, mask, sink)
    return o.reshape(B, T, ATT_WIDTH), kk[:, T:], vv[:, T:]


def _hgrn_chunk(s0, q, k, v, logf):
    s0 = s0.astype(jnp.float32)
    C = q.shape[2]
    b = jnp.cumsum(logf, axis=2)
    o = jnp.einsum('bhtd,bhde->bhte', q * jnp.exp(b), s0)
    causal = jnp.tril(jnp.ones((C, C), dtype=bool))[None, None, :, :, None]
    diff = b[:, :, :, None, :] - b[:, :, None, :, :]
    decay = jnp.exp(jnp.where(causal, diff, NEG_BIG))
    att = jnp.einsum('bhtd,bhtsd,bhsd->bhts', q, decay, k)
    o = o + jnp.einsum('bhts,bhse->bhte', att, v)
    b_end = b[:, :, -1:, :]
    s_new = jnp.exp(b_end[:, :, 0, :])[..., None] * s0 + jnp.einsum('bhsd,bhse->bhde', k * jnp.exp(b_end - b), v)
    return s_new, o


def _hgrn_prompt(q, k, v, logf):
    B, S = q.shape[:2]
    nc = S // HG_CHUNK

    def to_chunks(t):
        return t.reshape(B, nc, HG_CHUNK, HG_HEADS, t.shape[-1]).transpose(1, 0, 3, 2, 4)

    s0 = jnp.zeros((B, HG_HEADS, HG_DK, HG_DV), jnp.float32)
    s_fin, o = lax.scan(lambda s, xs: _hgrn_chunk(s, *xs), s0,
                        (to_chunks(q), to_chunks(k), to_chunks(v), to_chunks(logf)))
    o = o.transpose(1, 0, 3, 2, 4).reshape(B, S, HG_HEADS, HG_DV)
    return o, s_fin


def _hgrn_sample(q, k, v, logf, state):
    tr = lambda t: t.transpose(0, 2, 1, 3)
    s_new, o = _hgrn_chunk(state, tr(q), tr(k), tr(v), tr(logf))
    return tr(o), s_new


def _layer(x, cache_k, cache_v, state, lb, w_in, b_gate, attn_sink, hg_norm_w,
           w_up_attn, w_up_hgrn, w_out, ln1_g, ln1_b, w_ff1, w_ff2, ln2_g, ln2_b):
    Bn, T, _ = x.shape
    z = x @ w_in
    offsets = [int(o) for o in np.cumsum(SPLIT_SIZES)[:-1]]
    aq, ak, av, hq, hf, hi, hg, gates = jnp.split(z, offsets, axis=-1)
    aq = aq.reshape(Bn, T, KV_HEADS, Q_PER_KV, HEAD_DIM)
    ak = ak.reshape(Bn, T, KV_HEADS, HEAD_DIM)
    av = av.reshape(Bn, T, KV_HEADS, HEAD_DIM)
    hf32 = hf.astype(jnp.float32)
    logf = jnp.logaddexp(jnp.log(jnp.maximum(lb, LB_FLOOR)), jnp.log1p(-lb) + jax.nn.log_sigmoid(hf32))
    hk = (1.0 - lb) * jax.nn.sigmoid(-hf32)
    hq32 = jax.nn.silu(hq.astype(jnp.float32))
    heads = lambda t, d: t.reshape(Bn, T, HG_HEADS, d)
    hq32, hk, logf = heads(hq32, HG_DK), heads(hk, HG_DK), heads(logf, HG_DK)
    hv = heads(hi.astype(jnp.float32), HG_DV)
    if cache_k is None:
        a_out = _window_attn_prompt(aq, ak, av, attn_sink)
        W = min(WINDOW, T)
        new_k, new_v = ak[:, T - W:], av[:, T - W:]
        h_o, new_s = _hgrn_prompt(hq32, hk, hv, logf)
    else:
        a_out, new_k, new_v = _window_attn_sample(aq, ak, av, cache_k, cache_v, attn_sink)
        h_o, new_s = _hgrn_sample(hq32, hk, hv, logf, state)
    h_out = (_rms_norm(h_o, hg_norm_w).reshape(Bn, T, HG_VAL_WIDTH)
             * jax.nn.silu(hg.astype(jnp.float32)))
    g = jax.nn.sigmoid(gates.astype(jnp.float32) + b_gate.astype(jnp.float32))
    g_a, g_h = g[..., :D_MODEL], g[..., D_MODEL:]
    merged = (g_a * (a_out.astype(x.dtype) @ w_up_attn).astype(jnp.float32)
              + g_h * (h_out.astype(x.dtype) @ w_up_hgrn).astype(jnp.float32))
    m = merged.astype(x.dtype) @ w_out
    x = _layer_norm(DEEPNORM_ALPHA * x + m, ln1_g, ln1_b)
    ff = jnp.square(jax.nn.relu(x @ w_ff1)) @ w_ff2
    x = _layer_norm(DEEPNORM_ALPHA * x + ff, ln2_g, ln2_b)
    return x, new_k, new_v, new_s


def setup_inputs(seed: int = 0) -> dict:
    key = jax.random.key(seed)
    ks = jax.random.split(key, 24)
    n = lambda k, shape, s=1.0: jax.random.normal(k, shape, jnp.float32) * s
    cw = min(WINDOW, PAST_LEN)
    return {
        "x_prompt": n(ks[0], (BATCH, SEQ, D_MODEL)),
        "x_sample": n(ks[1], (DEC_BATCH, DEC_SEQ, D_MODEL)),
        "cache_k": n(ks[2], (DEPTH, DEC_BATCH, cw, KV_HEADS, HEAD_DIM)),
        "cache_v": n(ks[3], (DEPTH, DEC_BATCH, cw, KV_HEADS, HEAD_DIM)),
        "state_hgrn": n(ks[4], (DEPTH, DEC_BATCH, HG_HEADS, HG_DK, HG_DV), 0.5),
        "w_in": n(ks[5], (DEPTH, D_MODEL, IN_COLS), D_MODEL ** -0.5),
        "b_gate": n(ks[6], (DEPTH, N_BRANCH * D_MODEL), 0.1),
        "attn_sink": n(ks[7], (DEPTH, N_HEADS), 0.5),
        "hgrn_lb_logits": n(ks[8], (DEPTH, HG_KEY_WIDTH), 0.5),
        "hgrn_norm_w": 1.0 + n(ks[9], (DEPTH, HG_DV), 0.1),
        "w_up_attn": n(ks[10], (DEPTH, ATT_WIDTH, D_MODEL), ATT_WIDTH ** -0.5),
        "w_up_hgrn": n(ks[11], (DEPTH, HG_VAL_WIDTH, D_MODEL), HG_VAL_WIDTH ** -0.5),
        "w_out": n(ks[12], (DEPTH, D_MODEL, D_MODEL), D_MODEL ** -0.5 * DEEPNORM_BETA),
        "ln1_g": 1.0 + n(ks[13], (DEPTH, D_MODEL), 0.1),
        "ln1_b": n(ks[14], (DEPTH, D_MODEL), 0.1),
        "w_ff1": n(ks[15], (DEPTH, D_MODEL, D_FF), D_MODEL ** -0.5),
        "w_ff2": n(ks[16], (DEPTH, D_FF, D_MODEL), D_FF ** -0.5 * DEEPNORM_BETA),
        "ln2_g": 1.0 + n(ks[17], (DEPTH, D_MODEL), 0.1),
        "ln2_b": n(ks[18], (DEPTH, D_MODEL), 0.1),
    }


def reference(x_prompt, x_sample, cache_k, cache_v, state_hgrn, w_in, b_gate, attn_sink,
              hgrn_lb_logits, hgrn_norm_w, w_up_attn, w_up_hgrn, w_out, ln1_g, ln1_b,
              w_ff1, w_ff2, ln2_g, ln2_b):
    p = jax.nn.softmax(hgrn_lb_logits.astype(jnp.float32), axis=0)
    lb_all = jnp.cumsum(p, axis=0) - p[0]
    xp, xs = x_prompt, x_sample
    pk, pv, ps, sk, sv, ss = [], [], [], [], [], []
    for l in range(DEPTH):
        wl = (w_in[l], b_gate[l], attn_sink[l], hgrn_norm_w[l], w_up_attn[l], w_up_hgrn[l],
              w_out[l], ln1_g[l], ln1_b[l], w_ff1[l], w_ff2[l], ln2_g[l], ln2_b[l])
        xp, k1, v1, s1 = _layer(xp, None, None, None, lb_all[l], *wl)
        xs, k2, v2, s2 = _layer(xs, cache_k[l], cache_v[l], state_hgrn[l], lb_all[l], *wl)
        pk.append(k1); pv.append(v1); ps.append(s1)
        sk.append(k2); sv.append(v2); ss.append(s2)
    return (xp, xs, jnp.stack(pk), jnp.stack(pv), jnp.stack(ps), jnp.stack(sk), jnp.stack(sv), jnp.stack(ss))
```

```cpp
#include <hip/hip_runtime.h>
#include <hip/hip_cooperative_groups.h>
#include <cstdio>
#include <cstdint>
namespace cg = cooperative_groups;
namespace pg8 {
#define PG8_LAS __attribute__((address_space(3)))
typedef unsigned short bf16_t;
typedef short bf16x8 __attribute__((ext_vector_type(8)));
typedef float f32x4 __attribute__((ext_vector_type(4)));
typedef unsigned u32x4 __attribute__((ext_vector_type(4)));
constexpr int BM = 256, BK = 64, HALF = 128, HTB = HALF * BK * 2  , STAGE_BYTES = 8 * HTB, NXCD = 8, WGM = 8;

__host__ __device__ __forceinline__ int lds_byte(int r, int c) { const int st = (r >> 4) * 2 + (c >> 5), rr = r & 15, cc = c & 31, ob = rr * 64 + cc * 2; return st * 1024 + (ob ^ (((ob >> 9) & 1) << 5)); }
__host__ __device__ __forceinline__ void stage_rc(int b, int& R, int& C) { const int st = b / 1024, sb = b % 1024, swz = sb ^ (((sb >> 9) & 1) << 5); R = (st >> 1) * 16 + swz / 64; C = (st & 1) * 32 + (swz % 64) / 2; }
__host__ __device__ __forceinline__ int perm32(int rho) { const int n = rho >> 4, i = rho & 15; return 8 * (i >> 2) + 4 * n + (i & 3); }

struct Unit { int pm, pn; };
struct Gemm { const bf16_t* A; const bf16_t* Bt; int M, N, K, lda, ldb; };

struct StaticOrder {
    int nM, nN, nwg, G, c;
    __host__ __device__ void init(int M, int N, int G_, int c_) { nM = M / BM; nN = N / BM; nwg = nM * nN; G = G_; c = c_; }
    __host__ __device__ bool next(int i, Unit& u) const {
        const long L = (long)i * G + c; if (L >= nwg) return false;
        int wgid = (int)L; { const int q = nwg / NXCD, r = nwg % NXCD, xcd = wgid % NXCD, off = wgid / NXCD; wgid = (xcd < r ? xcd * (q + 1) : r * (q + 1) + (xcd - r) * q) + off; }
        const int nig = WGM * nN, gid = wgid / nig, fm = gid * WGM, gsz = (nM - fm) < WGM ? (nM - fm) : WGM;
        u.pm = fm + ((wgid % nig) % gsz); u.pn = (wgid % nig) / gsz; return true;
    }
    __device__ __forceinline__ void a_ready(const Unit&) const {}
    __device__ __forceinline__ void done(const Unit&) const {}
};

template <class Epi, class Sched, bool ALIGN_EPI = false, bool SP2 = false>
__device__ __forceinline__ void gemm_phase(PG8_LAS unsigned char* lds, const Gemm g, const Sched& S, const Epi& E) {
    int tid_op = threadIdx.x; asm volatile("" : "+v"(tid_op));
    const int tid = tid_op, wid = __builtin_amdgcn_readfirstlane(tid >> 6), lane = tid & 63, wr = wid >> 2, wc = wid & 3, fr = lane & 15, fq = lane >> 4;
    const int K = g.K, nt = K / BK;
    unsigned voffA[2], voffB[2];
#pragma unroll
    for (int i = 0; i < 2; ++i) { int R, C; stage_rc(tid * 16 + i * 8192, R, C); const int Rb = Epi::PERM ? ((R & ~31) + perm32(R & 31)) : R;
        voffA[i] = (unsigned)(R * g.lda + C) * 2u; voffB[i] = (unsigned)(Rb * g.ldb + C) * 2u; }
    const size_t kstep = (size_t)(BK * 2);
    const size_t hstepA = (size_t)HALF * g.lda * 2, hstepB = (size_t)HALF * g.ldb * 2;
    const size_t tstepA = 2 * hstepA, tstepB = 2 * hstepB;
    const unsigned ldsw = (unsigned)wid * 1024u;
    const int aoff = lds_byte(wr * 64 + fr, fq * 8), boff = lds_byte(wc * 32 + fr, fq * 8);
#define PG8_SA(b, h) (((b) * 2 + (h)) * HTB)
#define PG8_SB(b, h) ((4 + (b) * 2 + (h)) * HTB)
#define PG8_STAGE(bufoff, gbase, voff) do { _Pragma("unroll") for (int _i = 0; _i < 2; ++_i) \
        __builtin_amdgcn_global_load_lds((const unsigned*)((const char*)(gbase) + (voff)[_i]), (PG8_LAS unsigned*)(lds + (bufoff) + ldsw + _i * 8192), 16, 0, 0); } while (0)
#define PG8_LDA(dst, b, h) do { _Pragma("unroll") for (int m = 0; m < 4; ++m) _Pragma("unroll") for (int k = 0; k < 2; ++k) dst[m][k] = *(const PG8_LAS bf16x8*)(lds + PG8_SA(b, h) + aoff + m * 2048 + k * 1024); } while (0)
#define PG8_LDB(dst, b, h) do { _Pragma("unroll") for (int n = 0; n < 2; ++n) _Pragma("unroll") for (int k = 0; k < 2; ++k) dst[n][k] = *(const PG8_LAS bf16x8*)(lds + PG8_SB(b, h) + boff + n * 2048 + k * 1024); } while (0)
#define PG8_MMA(ai, bj, At, Bt) do { __builtin_amdgcn_s_setprio(1); _Pragma("unroll") for (int m = 0; m < 4; ++m) _Pragma("unroll") for (int n = 0; n < 2; ++n) _Pragma("unroll") for (int k = 0; k < 2; ++k) \
        acc[ai][bj][m][n] = __builtin_amdgcn_mfma_f32_16x16x32_bf16(Bt[n][k], At[m][k], acc[ai][bj][m][n], 0, 0, 0); __builtin_amdgcn_s_setprio(0); } while (0)
#define PG8_WAIT_V(n) asm volatile("s_waitcnt vmcnt(" #n ")" ::: "memory")
#define PG8_WAIT_L(n) asm volatile("s_waitcnt lgkmcnt(" #n ")" ::: "memory")
#define PG8_BAR __builtin_amdgcn_s_barrier()
#define PG8_SCHED __builtin_amdgcn_sched_barrier(0)
    Unit cur, nxt; int ui = 0;
    if (!S.next(0, cur)) return;
    f32x4 acc[2][2][4][2];
#pragma unroll
    for (int a = 0; a < 2; ++a)
#pragma unroll
        for (int b = 0; b < 2; ++b)
#pragma unroll
            for (int m = 0; m < 4; ++m)
#pragma unroll
                for (int n = 0; n < 2; ++n) acc[a][b][m][n] = (f32x4){0.f, 0.f, 0.f, 0.f};
    bf16x8 At[4][2], B0[2][2], B1[2][2];
    const char* cA = (const char*)g.A + (size_t)cur.pm * tstepA; const char* cB = (const char*)g.Bt + (size_t)cur.pn * tstepB;
    S.a_ready(cur);
    if constexpr (SP2) {
        PG8_STAGE(PG8_SB(0, 0), cB, voffB); PG8_STAGE(PG8_SB(0, 1), cB + hstepB, voffB); PG8_STAGE(PG8_SA(0, 0), cA, voffA); PG8_STAGE(PG8_SA(0, 1), cA + hstepA, voffA);
        if (wr == 1) PG8_BAR;
        PG8_WAIT_V(2); PG8_BAR;
        PG8_STAGE(PG8_SB(1, 0), cB + kstep, voffB); PG8_STAGE(PG8_SA(1, 0), cA + kstep, voffA); PG8_STAGE(PG8_SB(1, 1), cB + hstepB + kstep, voffB);
        PG8_WAIT_V(6); PG8_BAR;
    } else {
        PG8_STAGE(PG8_SB(0, 0), cB, voffB); PG8_STAGE(PG8_SA(0, 0), cA, voffA); PG8_STAGE(PG8_SB(0, 1), cB + hstepB, voffB); PG8_STAGE(PG8_SA(0, 1), cA + hstepA, voffA);
        if (wr == 1) PG8_BAR;
        PG8_WAIT_V(4); PG8_BAR;
        PG8_STAGE(PG8_SB(1, 0), cB + kstep, voffB); PG8_STAGE(PG8_SA(1, 0), cA + kstep, voffA); PG8_STAGE(PG8_SB(1, 1), cB + hstepB + kstep, voffB);
        PG8_WAIT_V(6); PG8_BAR;
    }
    for (;;) {
        const bool has_next = S.next(ui + 1, nxt);
        const char* nA = has_next ? (const char*)g.A + (size_t)nxt.pm * tstepA : cA; const char* nB = has_next ? (const char*)g.Bt + (size_t)nxt.pn * tstepB : cB;
        for (int t = 0; t < nt; t += 2) {
            const bool last = (t == nt - 2);
            const char* a1 = cA + (size_t)(t + 1) * kstep;
            const char* a2 = last ? nA : cA + (size_t)(t + 2) * kstep; const char* b2 = last ? nB : cB + (size_t)(t + 2) * kstep;
            const char* a3 = a2 + kstep; const char* b3 = b2 + kstep;
            if (last && has_next) S.a_ready(nxt);
            if constexpr (SP2) {
            PG8_LDB(B0, 0, 0); PG8_LDB(B1, 0, 1); PG8_SCHED; PG8_LDA(At, 0, 0); PG8_STAGE(PG8_SA(1, 1), a1 + hstepA, voffA);
            PG8_WAIT_V(8); PG8_WAIT_L(0); PG8_BAR; PG8_MMA(0, 0, At, B0); PG8_MMA(0, 1, At, B1); PG8_BAR; PG8_SCHED;
            PG8_LDA(At, 0, 1); PG8_STAGE(PG8_SB(0, 0), b2, voffB); PG8_STAGE(PG8_SB(0, 1), b2 + hstepB, voffB); PG8_STAGE(PG8_SA(0, 0), a2, voffA);
            PG8_WAIT_V(8); PG8_WAIT_L(0); PG8_BAR; PG8_MMA(1, 0, At, B0); PG8_MMA(1, 1, At, B1); PG8_BAR; PG8_SCHED;
            PG8_LDB(B0, 1, 0); PG8_LDB(B1, 1, 1); PG8_SCHED; PG8_LDA(At, 1, 0); PG8_STAGE(PG8_SA(0, 1), a2 + hstepA, voffA);
            PG8_WAIT_V(8); PG8_WAIT_L(0); PG8_BAR; PG8_MMA(0, 0, At, B0); PG8_MMA(0, 1, At, B1); PG8_BAR; PG8_SCHED;
            PG8_LDA(At, 1, 1); PG8_STAGE(PG8_SB(1, 0), b3, voffB); PG8_STAGE(PG8_SB(1, 1), b3 + hstepB, voffB); PG8_STAGE(PG8_SA(1, 0), a3, voffA);
            PG8_WAIT_V(8); PG8_WAIT_L(0); PG8_BAR; PG8_MMA(1, 0, At, B0); PG8_MMA(1, 1, At, B1); PG8_BAR; PG8_SCHED;
            } else {
            PG8_LDB(B0, 0, 0); PG8_SCHED; PG8_LDA(At, 0, 0); PG8_STAGE(PG8_SA(1, 1), a1 + hstepA, voffA);
            PG8_WAIT_L(8); PG8_BAR; PG8_WAIT_L(0); PG8_MMA(0, 0, At, B0); PG8_BAR; PG8_SCHED;
            PG8_LDB(B1, 0, 1); PG8_STAGE(PG8_SB(0, 0), b2, voffB);
            PG8_BAR; PG8_WAIT_L(0); PG8_MMA(0, 1, At, B1); PG8_BAR;
            PG8_LDA(At, 0, 1); PG8_STAGE(PG8_SA(0, 0), a2, voffA);
            PG8_BAR; PG8_WAIT_L(0); PG8_MMA(1, 0, At, B0); PG8_BAR; PG8_SCHED;
            PG8_STAGE(PG8_SB(0, 1), b2 + hstepB, voffB);
            PG8_WAIT_V(6); PG8_BAR; PG8_MMA(1, 1, At, B1); PG8_BAR;
            PG8_LDB(B0, 1, 0); PG8_SCHED; PG8_LDA(At, 1, 0); PG8_STAGE(PG8_SA(0, 1), a2 + hstepA, voffA);
            PG8_WAIT_L(8); PG8_BAR; PG8_WAIT_L(0); PG8_MMA(0, 0, At, B0); PG8_BAR; PG8_SCHED;
            PG8_LDB(B1, 1, 1); PG8_STAGE(PG8_SB(1, 0), b3, voffB);
            PG8_BAR; PG8_WAIT_L(0); PG8_MMA(0, 1, At, B1); PG8_BAR;
            PG8_LDA(At, 1, 1); PG8_STAGE(PG8_SA(1, 0), a3, voffA);
            PG8_BAR; PG8_WAIT_L(0); PG8_MMA(1, 0, At, B0); PG8_BAR; PG8_SCHED;
            PG8_STAGE(PG8_SB(1, 1), b3 + hstepB, voffB);
            PG8_WAIT_V(6); PG8_BAR; PG8_MMA(1, 1, At, B1); PG8_BAR;
            }
        }
        if constexpr (ALIGN_EPI) { if (wr == 0) PG8_BAR; }
        if constexpr (!Epi::AFTER_DRAIN) { E(acc, cur, wr, wc, fr, fq); S.done(cur); }
        if (!has_next) break;
#pragma unroll
        for (int a = 0; a < 2; ++a)
#pragma unroll
            for (int b = 0; b < 2; ++b)
#pragma unroll
                for (int m = 0; m < 4; ++m)
#pragma unroll
                    for (int n = 0; n < 2; ++n) acc[a][b][m][n] = (f32x4){0.f, 0.f, 0.f, 0.f};
        cur = nxt; cA = nA; cB = nB; ++ui;
        if constexpr (ALIGN_EPI) { if (wr == 1) PG8_BAR; }
    }
    PG8_WAIT_V(0);
    if constexpr (!ALIGN_EPI) { if (wr == 0) PG8_BAR; }
    PG8_BAR;
    if constexpr (Epi::AFTER_DRAIN) { E.fused(acc, cur, wr, wc, fr, fq, lds, wid, lane); S.done(cur); }
#undef PG8_SA
#undef PG8_SB
#undef PG8_STAGE
#undef PG8_LDA
#undef PG8_LDB
#undef PG8_MMA
#undef PG8_WAIT_V
#undef PG8_WAIT_L
#undef PG8_BAR
#undef PG8_SCHED
}
}


#define DI __device__ __forceinline__
#define LAS __attribute__((address_space(3)))
using pg8::bf16_t; using pg8::bf16x8; using pg8::f32x4; using pg8::u32x4;
typedef float f32x2 __attribute__((ext_vector_type(2)));
typedef unsigned u32x2 __attribute__((ext_vector_type(2)));
typedef __bf16 bf2_t __attribute__((ext_vector_type(2)));

constexpr int MP = 16384, MS = 512, MT = MP + MS;
constexpr int DM = 1024, NIN = 4864, FF = 4096, DEPTH = 4;
constexpr float ALPHA = 1.681792830507429f;
constexpr float LN_EPS = 1e-5f, RMS_EPS = 1e-6f;
constexpr int NWAVES = 8, NTHREADS = 512;
constexpr int LDS_BYTES = 147456;

constexpr size_t O_Y = 0, O_PK = (size_t)MT * DM, O_PV = O_PK + 262144, O_PS = O_PV + 262144, O_SK = O_PS + 1048576, O_SV = O_SK + 8388608, O_SS = O_SV + 8388608;

constexpr size_t MiB = 1u << 20;
constexpr size_t WS_LBT = 0;
constexpr size_t WS_WIN = 1 * MiB, WS_WUP = 11 * MiB, WS_WOUT = 13 * MiB, WS_WFF1 = 15 * MiB, WS_WFF2 = 23 * MiB;
constexpr size_t WS_X = 31 * MiB;
constexpr size_t WS_XB = 97 * MiB;
constexpr size_t WS_G = 130 * MiB;
constexpr size_t WS_AH = 196 * MiB;
constexpr size_t WS_R = 229 * MiB;
constexpr size_t WS_HB = WS_R;
constexpr size_t WS_Y = WS_R + 132 * MiB;
constexpr size_t WS_MG = WS_R;
constexpr size_t WS_LOGF = WS_R + 34 * MiB;
constexpr size_t WS_HQ = WS_R + 67 * MiB, WS_HK = WS_R + 84 * MiB, WS_HV = WS_R + 101 * MiB, WS_HG = WS_R + 118 * MiB;
constexpr size_t WS_DST = WS_R + 135 * MiB;
constexpr size_t WS_SB = WS_R + 199 * MiB;
constexpr size_t WS_AQ = 460 * MiB;
constexpr size_t WS_AK = 477 * MiB, WS_AV = 482 * MiB;
constexpr size_t WS_DEC = 487 * MiB;
constexpr size_t WS_END = 488 * MiB;

struct Params {
    const float *x_prompt, *x_sample, *cache_k, *cache_v, *state, *w_in, *b_gate, *sink, *lb_logits, *norm_w, *w_upa, *w_uph, *w_out, *ln1g, *ln1b, *w_ff1, *w_ff2, *ln2g, *ln2b;
    float* out; unsigned char* ws;
};

DI unsigned pk2(float lo, float hi) { f32x2 v = {lo, hi}; bf2_t b = __builtin_convertvector(v, bf2_t); return __builtin_bit_cast(unsigned, b); }
DI bf16_t f2bf(float x) { return (bf16_t)(pk2(x, 0.f) & 0xffffu); }
DI float bf2f(bf16_t h) { return __uint_as_float((unsigned)h << 16); }
DI float bflo(unsigned w) { return __uint_as_float(w << 16); }
DI float bfhi(unsigned w) { return __uint_as_float(w & 0xffff0000u); }
DI void st_bf16x8(bf16_t* p, f32x4 a, f32x4 b) { u32x4 w; w.x = pk2(a[0], a[1]); w.y = pk2(a[2], a[3]); w.z = pk2(b[0], b[1]); w.w = pk2(b[2], b[3]); *(u32x4*)p = w; }
DI void ld_bf16x8(const bf16_t* p, f32x4& a, f32x4& b) { const u32x4 w = *(const u32x4*)p; a = (f32x4){bflo(w.x), bfhi(w.x), bflo(w.y), bfhi(w.y)}; b = (f32x4){bflo(w.z), bfhi(w.z), bflo(w.w), bfhi(w.w)}; }
DI float sigm(float x) { return 1.f / (1.f + __expf(-x)); }
DI float silu(float x) { return x / (1.f + __expf(-x)); }
DI float wave_sum(float v) {
#pragma unroll
    for (int o = 1; o < 64; o <<= 1) v += __shfl_xor(v, o);
    return v;
}
#define MFMA16(a, b, c) __builtin_amdgcn_mfma_f32_16x16x32_bf16((a), (b), (c), 0, 0, 0)
#define LDS_WAIT() asm volatile("s_waitcnt lgkmcnt(0)" ::: "memory")

#define EPI_ARGS const f32x4 (&acc)[2][2][4][2], const pg8::Unit& u, int wr, int wc, int fr, int fq
#define EPI_ROWS _Pragma("unroll") for (int ai = 0; ai < 2; ++ai) _Pragma("unroll") for (int m = 0; m < 4; ++m)
#define EPI_ROW (u.pm * 256 + ai * 128 + wr * 64 + m * 16 + fr)
#define EPI_COL(bj) (u.pn * 256 + (bj) * 128 + wc * 32 + 8 * fq)

struct Epi1 {
    static constexpr bool PERM = true, AFTER_DRAIN = false;
    bf16_t *AQ, *AK, *AV, *HQ, *HK, *HV, *HG, *G; float* LOGF; const float* LBT; const float* bgate; float *pk, *pv, *sk, *sv;
    template <int bj, int n> DI void hf_part(EPI_ARGS) const {
        const int d0 = EPI_COL(bj) - 1280 + 4 * n;
        f32x4 lb[4];
#pragma unroll
        for (int j = 0; j < 4; ++j) lb[j] = *(const f32x4*)(LBT + (size_t)(d0 + j) * 4);
        EPI_ROWS { const size_t row = EPI_ROW; f32x4 lo, ko;
#pragma unroll
            for (int j = 0; j < 4; ++j) { const float hf = acc[ai][bj][m][n][j]; const f32x4 L = lb[j];
                const float ls = fminf(hf, 0.f) - __logf(1.f + __expf(-fabsf(hf)));
                const float bb = L[2] + ls, mx = fmaxf(L[1], bb); lo[j] = mx + __logf(1.f + __expf(-fabsf(L[1] - bb)));
                ko[j] = (1.f - L[0]) / (1.f + __expf(hf)); }
            *(f32x4*)(LOGF + row * 512 + d0) = lo;
            u32x2 w; w.x = pk2(ko[0], ko[1]); w.y = pk2(ko[2], ko[3]); *(u32x2*)(HK + row * 512 + d0) = w;
            asm volatile("" ::: "memory"); }
    }
    DI void operator()(EPI_ARGS) const {
        const int pn = u.pn;
        if (pn < 2) {
            EPI_ROWS { const size_t row = EPI_ROW;
#pragma unroll
                for (int bj = 0; bj < 2; ++bj) st_bf16x8(AQ + row * 512 + EPI_COL(bj), acc[ai][bj][m][0] * 0.125f, acc[ai][bj][m][1] * 0.125f); }
        } else if (pn == 2) {
            EPI_ROWS { const int row = EPI_ROW;
#pragma unroll
                for (int bj = 0; bj < 2; ++bj) { const int lc = wc * 32 + 8 * fq; const f32x4 v0 = acc[ai][bj][m][0], v1 = acc[ai][bj][m][1];
                    st_bf16x8((bj == 0 ? AK : AV) + (size_t)row * 128 + lc, v0, v1);
                    float* o = nullptr;
                    if (row < MP) { const int t = row & 4095, b = row >> 12; if (t >= 3968) o = (bj == 0 ? pk : pv) + (size_t)(b * 128 + t - 3968) * 128 + lc; }
                    else { const int r = row - MP; o = (bj == 0 ? sk : sv) + (size_t)((r >> 2) * 128 + 124 + (r & 3)) * 128 + lc; }
                    if (o) { *(f32x4*)o = v0; *(f32x4*)(o + 4) = v1; } } }
        } else if (pn < 5 || (pn >= 9 && pn < 11)) {
            bf16_t* dst = pn < 5 ? HQ : HG; const int cb = pn < 5 ? 768 : 2304;
            EPI_ROWS { const size_t row = EPI_ROW;
#pragma unroll
                for (int bj = 0; bj < 2; ++bj) { f32x4 v0 = acc[ai][bj][m][0], v1 = acc[ai][bj][m][1];
#pragma unroll
                    for (int j = 0; j < 4; ++j) { v0[j] = silu(v0[j]); v1[j] = silu(v1[j]); }
                    st_bf16x8(dst + row * 512 + (EPI_COL(bj) - cb), v0, v1); } }
        } else if (pn < 7) {
            hf_part<0, 0>(acc, u, wr, wc, fr, fq); hf_part<0, 1>(acc, u, wr, wc, fr, fq); hf_part<1, 0>(acc, u, wr, wc, fr, fq); hf_part<1, 1>(acc, u, wr, wc, fr, fq);
        } else if (pn < 9) {
            EPI_ROWS { const size_t row = EPI_ROW;
#pragma unroll
                for (int bj = 0; bj < 2; ++bj) st_bf16x8(HV + row * 512 + (EPI_COL(bj) - 1792), acc[ai][bj][m][0], acc[ai][bj][m][1]); }
        } else {
#pragma unroll
            for (int bj = 0; bj < 2; ++bj) { const int gc = EPI_COL(bj) - 2816; const f32x4 b0 = *(const f32x4*)(bgate + gc), b1 = *(const f32x4*)(bgate + gc + 4);
                EPI_ROWS { const size_t row = EPI_ROW; f32x4 v0 = acc[ai][bj][m][0] + b0, v1 = acc[ai][bj][m][1] + b1;
#pragma unroll
                    for (int j = 0; j < 4; ++j) { v0[j] = sigm(v0[j]); v1[j] = sigm(v1[j]); }
                    st_bf16x8(G + row * 2048 + gc, v0, v1); } }
        }
    }
};
struct EpiUp1 {
    static constexpr bool PERM = true, AFTER_DRAIN = false;
    const bf16_t* G; float* T;
    DI void operator()(EPI_ARGS) const {
        EPI_ROWS { const size_t row = EPI_ROW;
#pragma unroll
            for (int bj = 0; bj < 2; ++bj) { const int c = EPI_COL(bj); f32x4 g0, g1; ld_bf16x8(G + row * 2048 + c, g0, g1);
                *(f32x4*)(T + row * 1024 + c) = g0 * acc[ai][bj][m][0]; *(f32x4*)(T + row * 1024 + c + 4) = g1 * acc[ai][bj][m][1]; } asm volatile("" ::: "memory"); }
    }
};
struct EpiUp2 {
    static constexpr bool PERM = true, AFTER_DRAIN = false;
    const bf16_t* G; const float* T; bf16_t* MG;
    DI void operator()(EPI_ARGS) const {
        EPI_ROWS { const size_t row = EPI_ROW;
#pragma unroll
            for (int bj = 0; bj < 2; ++bj) { const int c = EPI_COL(bj); f32x4 g0, g1; ld_bf16x8(G + row * 2048 + 1024 + c, g0, g1);
                const f32x4 t0 = *(const f32x4*)(T + row * 1024 + c), t1 = *(const f32x4*)(T + row * 1024 + c + 4);
                st_bf16x8(MG + row * 1024 + c, t0 + g0 * acc[ai][bj][m][0], t1 + g1 * acc[ai][bj][m][1]); } asm volatile("" ::: "memory"); }
    }
};
struct EpiRes {
    static constexpr bool PERM = true, AFTER_DRAIN = false;
    const float* X; float* Y;
    DI void operator()(EPI_ARGS) const {
        EPI_ROWS { const size_t row = EPI_ROW;
#pragma unroll
            for (int bj = 0; bj < 2; ++bj) { const int c = EPI_COL(bj);
                const f32x4 x0 = *(const f32x4*)(X + row * 1024 + c), x1 = *(const f32x4*)(X + row * 1024 + c + 4);
                *(f32x4*)(Y + row * 1024 + c) = x0 * ALPHA + acc[ai][bj][m][0]; *(f32x4*)(Y + row * 1024 + c + 4) = x1 * ALPHA + acc[ai][bj][m][1]; } asm volatile("" ::: "memory"); }
    }
};
struct EpiRelu2 {
    static constexpr bool PERM = true, AFTER_DRAIN = false;
    bf16_t* HB;
    DI void operator()(EPI_ARGS) const {
        EPI_ROWS { const size_t row = EPI_ROW;
#pragma unroll
            for (int bj = 0; bj < 2; ++bj) { f32x4 v0 = acc[ai][bj][m][0], v1 = acc[ai][bj][m][1];
#pragma unroll
                for (int j = 0; j < 4; ++j) { const float a = fmaxf(v0[j], 0.f), b = fmaxf(v1[j], 0.f); v0[j] = a * a; v1[j] = b * b; }
                st_bf16x8(HB + row * 4096 + EPI_COL(bj), v0, v1); } asm volatile("" ::: "memory"); }
    }
};

constexpr int PARAM_LDS_OFF = 131072 + 1024;
struct Ctx {
    LAS unsigned char* lds0;
    DI unsigned long long ptr(int i) const { unsigned off = PARAM_LDS_OFF + 8 * i; asm volatile("" : "+s"(off));
        volatile LAS const unsigned* q = (volatile LAS const unsigned*)(lds0 + off);
        const unsigned lo = __builtin_amdgcn_readfirstlane(q[0]), hi = __builtin_amdgcn_readfirstlane(q[1]); return ((unsigned long long)hi << 32) | lo; }
    DI const float* in(int i) const { return (const float*)ptr(i); }
    DI float* out() const { return (float*)ptr(19); }
    DI unsigned char* ws() const { return (unsigned char*)ptr(20); }
#define CTXP(T, name, off) DI T* name() const { return (T*)(ws() + (off)); }
    CTXP(float, X, WS_X) CTXP(float, Y, WS_Y) CTXP(float, LOGF, WS_LOGF) CTXP(float, DST, WS_DST) CTXP(float, DEC, WS_DEC) CTXP(float, LBT, WS_LBT)
    CTXP(bf16_t, XB, WS_XB) CTXP(bf16_t, G, WS_G) CTXP(bf16_t, AH, WS_AH) CTXP(bf16_t, HB, WS_HB) CTXP(bf16_t, MG, WS_MG) CTXP(bf16_t, HQ, WS_HQ) CTXP(bf16_t, HK, WS_HK)
    CTXP(bf16_t, HV, WS_HV) CTXP(bf16_t, HG, WS_HG) CTXP(bf16_t, SB, WS_SB) CTXP(bf16_t, AQ, WS_AQ) CTXP(bf16_t, AK, WS_AK) CTXP(bf16_t, AV, WS_AV)
    CTXP(bf16_t, WIN, WS_WIN) CTXP(bf16_t, WUP, WS_WUP) CTXP(bf16_t, WOUT, WS_WOUT) CTXP(bf16_t, WFF1, WS_WFF1) CTXP(bf16_t, WFF2, WS_WFF2)
#undef CTXP
};
enum { I_XP = 0, I_XS, I_CK, I_CV, I_ST, I_WIN, I_BG, I_SINK, I_LB, I_NW, I_WUA, I_WUH, I_WOUT, I_L1G, I_L1B, I_WF1, I_WF2, I_L2G, I_L2B };

DI void transpose_item(const float* W, int N, bf16_t* WT, int ldt, int koff, LAS float* scr, int item, int lane) {
    const int nblk = N / 32, kb = item / nblk, nb = item % nblk, k0 = 64 * kb, n0 = 32 * nb;
#pragma unroll 8
    for (int i = 0; i < 32; ++i) { const int kk = 2 * i + (lane >> 5); scr[kk * 33 + (lane & 31)] = W[(size_t)(k0 + kk) * N + n0 + (lane & 31)]; }
    LDS_WAIT();
    const int c = lane & 7;
#pragma unroll
    for (int j = 0; j < 4; ++j) { const int n = (lane >> 3) + 8 * j; const LAS float* s = scr + (8 * c) * 33 + n;
        u32x4 o; o.x = pk2(s[0 * 33], s[1 * 33]); o.y = pk2(s[2 * 33], s[3 * 33]); o.z = pk2(s[4 * 33], s[5 * 33]); o.w = pk2(s[6 * 33], s[7 * 33]);
        *(u32x4*)(WT + (size_t)(n0 + n) * ldt + koff + k0 + 8 * c) = o; }
    LDS_WAIT();
}
DI void convert_layer(const Ctx& c, int l, LAS unsigned char* lds, int gw, int ngw, int wave, int lane) {
    LAS float* scr = (LAS float*)(lds + wave * 16384);
    constexpr int I_IN = (DM / 64) * (NIN / 32), I_UP = (512 / 64) * (DM / 32), I_OUT = (DM / 64) * (DM / 32), I_F1 = (DM / 64) * (FF / 32), I_F2 = (FF / 64) * (DM / 32);
    constexpr int NITEMS = I_IN + 2 * I_UP + I_OUT + I_F1 + I_F2;
    for (int it = gw; it < NITEMS; it += ngw) {
        int r = it;
        if (r < I_IN) { transpose_item(c.in(I_WIN) + (size_t)l * DM * NIN, NIN, c.WIN(), DM, 0, scr, r, lane); continue; } r -= I_IN;
        if (r < I_UP) { transpose_item(c.in(I_WUA) + (size_t)l * 512 * DM, DM, c.WUP(), DM, 0, scr, r, lane); continue; } r -= I_UP;
        if (r < I_UP) { transpose_item(c.in(I_WUH) + (size_t)l * 512 * DM, DM, c.WUP(), DM, 512, scr, r, lane); continue; } r -= I_UP;
        if (r < I_OUT) { transpose_item(c.in(I_WOUT) + (size_t)l * DM * DM, DM, c.WOUT(), DM, 0, scr, r, lane); continue; } r -= I_OUT;
        if (r < I_F1) { transpose_item(c.in(I_WF1) + (size_t)l * DM * FF, FF, c.WFF1(), DM, 0, scr, r, lane); continue; } r -= I_F1;
        transpose_item(c.in(I_WF2) + (size_t)l * FF * DM, DM, c.WFF2(), FF, 0, scr, r, lane);
    }
}
DI void ln_row(const float* src, const float* g, const float* b, float* xrow, bf16_t* xbrow, float* extra, int lane, bool do_ln) {
    const f32x4* xr = (const f32x4*)src + lane;
    f32x4 v[4]; float s = 0.f;
#pragma unroll
    for (int j = 0; j < 4; ++j) { v[j] = xr[64 * j]; s += (v[j][0] + v[j][1]) + (v[j][2] + v[j][3]); }
    if (do_ln) {
        const float mean = wave_sum(s) * (1.f / DM); float s2 = 0.f;
#pragma unroll
        for (int j = 0; j < 4; ++j) { v[j] = v[j] - mean; s2 += (v[j][0] * v[j][0] + v[j][1] * v[j][1]) + (v[j][2] * v[j][2] + v[j][3] * v[j][3]); }
        const float rstd = 1.f / sqrtf(wave_sum(s2) * (1.f / DM) + LN_EPS);
#pragma unroll
        for (int j = 0; j < 4; ++j) { const f32x4 gg = ((const f32x4*)g)[lane + 64 * j], bb = ((const f32x4*)b)[lane + 64 * j]; v[j] = v[j] * rstd * gg + bb; }
    }
#pragma unroll
    for (int j = 0; j < 4; ++j) {
        ((f32x4*)xrow)[lane + 64 * j] = v[j];
        if (extra) ((f32x4*)extra)[lane + 64 * j] = v[j];
        u32x2 w; w.x = pk2(v[j][0], v[j][1]); w.y = pk2(v[j][2], v[j][3]); ((u32x2*)xbrow)[lane + 64 * j] = w;
    }
}

DI void attn_prompt_unit(const Ctx& c, const float* sink_l, int u, LAS unsigned char* lds, int tid) {
    const int wave = tid >> 6, lane = tid & 63, fr = lane & 15, fq = lane >> 4;
    const int b = u >> 6, blk = (u >> 1) & 31, kvh = u & 1;
    LAS bf16_t* Ks = (LAS bf16_t*)lds;
    LAS bf16_t* VT = (LAS bf16_t*)(lds + 36864);
    const int rowq0 = b * 4096 + blk * 128;
    __syncthreads();
#pragma unroll
    for (int i = 0; i < 4; ++i) { const int ch = tid + 512 * i, key = ch >> 3, dp = ch & 7;
        int t = (blk - 1) * 128 + key; if (t < 0) t = key;
        const size_t grow = (size_t)(b * 4096 + t);
        const u32x4 kv = *(const u32x4*)(c.AK() + grow * 128 + kvh * 64 + dp * 8);
        const u32x4 vv = *(const u32x4*)(c.AV() + grow * 128 + kvh * 64 + dp * 8);
        *(LAS u32x4*)(Ks + key * 72 + dp * 8) = kv;
        LAS bf16_t* vt = VT + (dp * 8) * 264 + key;
        vt[0 * 264] = (bf16_t)(vv.x & 0xffffu); vt[1 * 264] = (bf16_t)(vv.x >> 16); vt[2 * 264] = (bf16_t)(vv.y & 0xffffu); vt[3 * 264] = (bf16_t)(vv.y >> 16);
        vt[4 * 264] = (bf16_t)(vv.z & 0xffffu); vt[5 * 264] = (bf16_t)(vv.z >> 16); vt[6 * 264] = (bf16_t)(vv.w & 0xffffu); vt[7 * 264] = (bf16_t)(vv.w >> 16); }
    __syncthreads();
    const int lo = wave & ~1, qi = 16 * wave + fr;
#pragma unroll 1
    for (int g = 0; g < 4; ++g) {
        const float sink = sink_l[kvh * 4 + g];
        const bf16_t* qp = c.AQ() + (size_t)(rowq0 + qi) * 512 + (kvh * 4 + g) * 64 + 8 * fq;
        const bf16x8 q0 = *(const bf16x8*)qp, q1 = *(const bf16x8*)(qp + 32);
        f32x4 s[10]; float mx = sink;
#pragma unroll
        for (int t = 0; t < 10; ++t) { const LAS bf16_t* kp = Ks + (16 * (lo + t) + fr) * 72 + 8 * fq;
            const bf16x8 k0 = *(const LAS bf16x8*)kp, k1 = *(const LAS bf16x8*)(kp + 32);
            f32x4 a = {0.f, 0.f, 0.f, 0.f}; a = MFMA16(k0, q0, a); a = MFMA16(k1, q1, a);
#pragma unroll
            for (int i = 0; i < 4; ++i) { const int kj = 16 * (lo + t) + 4 * fq + i; const bool valid = (kj >= qi) && (kj <= qi + 128) && (blk > 0 || kj >= 128);
                a[i] = valid ? a[i] : -1e30f; mx = fmaxf(mx, a[i]); }
            s[t] = a; }
        mx = fmaxf(mx, __shfl_xor(mx, 16)); mx = fmaxf(mx, __shfl_xor(mx, 32));
        float sum = 0.f;
#pragma unroll
        for (int t = 0; t < 10; ++t)
#pragma unroll
            for (int i = 0; i < 4; ++i) { const float pe = __expf(s[t][i] - mx); s[t][i] = pe; sum += pe; }
        sum += __shfl_xor(sum, 16); sum += __shfl_xor(sum, 32);
        sum += __expf(sink - mx);
        const float inv = 1.f / sum;
        f32x4 o[4];
#pragma unroll
        for (int dt = 0; dt < 4; ++dt) o[dt] = (f32x4){0.f, 0.f, 0.f, 0.f};
#pragma unroll
        for (int j = 0; j < 5; ++j) { u32x4 pw; pw.x = pk2(s[2 * j][0] * inv, s[2 * j][1] * inv); pw.y = pk2(s[2 * j][2] * inv, s[2 * j][3] * inv);
            pw.z = pk2(s[2 * j + 1][0] * inv, s[2 * j + 1][1] * inv); pw.w = pk2(s[2 * j + 1][2] * inv, s[2 * j + 1][3] * inv);
            const bf16x8 pf = __builtin_bit_cast(bf16x8, pw);
#pragma unroll
            for (int dt = 0; dt < 4; ++dt) { const LAS bf16_t* vp = VT + (16 * dt + fr) * 264 + 16 * lo + 32 * j + 4 * fq;
                const u32x2 va = *(const LAS u32x2*)vp, vb = *(const LAS u32x2*)(vp + 16); u32x4 vw; vw.x = va.x; vw.y = va.y; vw.z = vb.x; vw.w = vb.y;
                o[dt] = MFMA16(__builtin_bit_cast(bf16x8, vw), pf, o[dt]); } }
#pragma unroll
        for (int dt = 0; dt < 4; ++dt) { bf16_t* op = c.AH() + (size_t)(rowq0 + qi) * 1024 + (kvh * 4 + g) * 64 + 16 * dt + 4 * fq;
            u32x2 w; w.x = pk2(o[dt][0], o[dt][1]); w.y = pk2(o[dt][2], o[dt][3]); *(u32x2*)op = w; }
    }
}
DI void attn_sample_unit(const Ctx& c, const float* sink_l, int l, int u, LAS unsigned char* lds, int tid) {
    const int wave = tid >> 6, lane = tid & 63;
    const int bs = u >> 1, kvh = u & 1;
    LAS float* Ksm = (LAS float*)lds;
    LAS float* Vsm = Ksm + 132 * 65;
    LAS float* Qsm = Vsm + 132 * 64;
    LAS float* Psm = Qsm + 16 * 64;
    const float* ck = c.in(I_CK) + ((size_t)(l * 128 + bs) * 128) * 128 + kvh * 64;
    const float* cv = c.in(I_CV) + ((size_t)(l * 128 + bs) * 128) * 128 + kvh * 64;
    float* ok = c.out() + O_SK + ((size_t)(l * 128 + bs) * 128) * 128 + kvh * 64;
    float* ov = c.out() + O_SV + ((size_t)(l * 128 + bs) * 128) * 128 + kvh * 64;
    __syncthreads();
#pragma unroll
    for (int i = 0; i < 4; ++i) { const int idx = tid + 512 * i, j = idx >> 4, d4 = (idx & 15) * 4;
        const f32x4 kk = *(const f32x4*)(ck + (size_t)j * 128 + d4), vv = *(const f32x4*)(cv + (size_t)j * 128 + d4);
        Ksm[j * 65 + d4 + 0] = kk[0]; Ksm[j * 65 + d4 + 1] = kk[1]; Ksm[j * 65 + d4 + 2] = kk[2]; Ksm[j * 65 + d4 + 3] = kk[3];
        Vsm[j * 64 + d4 + 0] = vv[0]; Vsm[j * 64 + d4 + 1] = vv[1]; Vsm[j * 64 + d4 + 2] = vv[2]; Vsm[j * 64 + d4 + 3] = vv[3];
        if (j >= 4) { *(f32x4*)(ok + (size_t)(j - 4) * 128 + d4) = kk; *(f32x4*)(ov + (size_t)(j - 4) * 128 + d4) = vv; } }
    if (tid < 256) { const int t = tid >> 6, d = tid & 63; const size_t row = (size_t)(MP + bs * 4 + t);
        Ksm[(128 + t) * 65 + d] = bf2f(c.AK()[row * 128 + kvh * 64 + d]); Vsm[(128 + t) * 64 + d] = bf2f(c.AV()[row * 128 + kvh * 64 + d]); }
#pragma unroll
    for (int i = 0; i < 2; ++i) { const int idx = tid + 512 * i, r = idx >> 6, d = idx & 63, t = r >> 2, g = r & 3;
        Qsm[r * 64 + d] = bf2f(c.AQ()[(size_t)(MP + bs * 4 + t) * 512 + (kvh * 4 + g) * 64 + d]); }
    __syncthreads();
    for (int e = tid; e < 16 * 132; e += 512) { const int r = e / 132, j = e - r * 132, t = r >> 2;
        float a = 0.f;
#pragma unroll 8
        for (int d = 0; d < 64; ++d) a += Qsm[r * 64 + d] * Ksm[j * 65 + d];
        const bool valid = (j >= t) && (j <= 128 + t);
        Psm[r * 136 + j] = valid ? a : -1e30f; }
    __syncthreads();
#pragma unroll
    for (int rr = 0; rr < 2; ++rr) { const int r = 2 * wave + rr, g = r & 3; const float sink = sink_l[kvh * 4 + g];
        float v[3]; float mx = sink;
#pragma unroll
        for (int k = 0; k < 3; ++k) { const int j = lane + 64 * k; v[k] = (j < 132) ? Psm[r * 136 + j] : -1e30f; mx = fmaxf(mx, v[k]); }
#pragma unroll
        for (int o = 1; o < 64; o <<= 1) mx = fmaxf(mx, __shfl_xor(mx, o));
        float sum = 0.f;
#pragma unroll
        for (int k = 0; k < 3; ++k) { v[k] = __expf(v[k] - mx); sum += v[k]; }
        sum = wave_sum(sum) + __expf(sink - mx);
        const float inv = 1.f / sum;
#pragma unroll
        for (int k = 0; k < 3; ++k) { const int j = lane + 64 * k; if (j < 132) Psm[r * 136 + j] = v[k] * inv; } }
    __syncthreads();
#pragma unroll
    for (int i = 0; i < 2; ++i) { const int o = tid + 512 * i, r = o >> 6, d = o & 63;
        float a = 0.f;
        for (int j = 0; j < 132; ++j) a += Psm[r * 136 + j] * Vsm[j * 64 + d];
        c.AH()[(size_t)(MP + bs * 4 + (r >> 2)) * 1024 + (kvh * 4 + (r & 3)) * 64 + d] = f2bf(a); }
}
DI void hg_cumsum(const float* LOGF, int r0, int h, int d, int seg, LAS float* segtot, float (&bcs)[16], float& bend, float& bmid) {
    const float* lp = LOGF + (size_t)(r0 + 16 * seg) * 512 + h * 128 + d;
#pragma unroll
    for (int i = 0; i < 16; ++i) bcs[i] = lp[(size_t)i * 512];
    float run = 0.f;
#pragma unroll
    for (int i = 0; i < 16; ++i) { run += bcs[i]; bcs[i] = run; }
    segtot[seg * 128 + d] = run;
    __syncthreads();
    const float s0 = segtot[d], s1 = segtot[128 + d], s2 = segtot[256 + d], s3 = segtot[384 + d];
    const float off = seg == 0 ? 0.f : seg == 1 ? s0 : seg == 2 ? (s0 + s1) : (s0 + s1 + s2);
#pragma unroll
    for (int i = 0; i < 16; ++i) bcs[i] += off;
    bend = (s0 + s1) + (s2 + s3); bmid = s0 + s1;
}
DI void hg_pass1_unit(const Ctx& c, int u, LAS unsigned char* lds, int tid) {
    const int wave = tid >> 6, lane = tid & 63, fr = lane & 15, fq = lane >> 4;
    const int bh = u >> 6, ci = u & 63, bb = bh >> 2, h = bh & 3, r0 = bb * 4096 + 64 * ci;
    LAS bf16_t* KT = (LAS bf16_t*)lds;
    LAS bf16_t* VT = KT + 128 * 72;
    LAS float* segtot = (LAS float*)(lds + 2 * 128 * 72 * 2);
    const int d = tid & 127, seg = tid >> 7;
    __syncthreads();
    float bcs[16], bend, bmid; hg_cumsum(c.LOGF(), r0, h, d, seg, segtot, bcs, bend, bmid);
    const bf16_t* kp = c.HK() + (size_t)(r0 + 16 * seg) * 512 + h * 128 + d;
    const bf16_t* vp = c.HV() + (size_t)(r0 + 16 * seg) * 512 + h * 128 + d;
    unsigned kw[8], vw[8];
#pragma unroll
    for (int i = 0; i < 8; ++i) { const float k0 = bf2f(kp[(size_t)(2 * i) * 512]) * __expf(bend - bcs[2 * i]), k1 = bf2f(kp[(size_t)(2 * i + 1) * 512]) * __expf(bend - bcs[2 * i + 1]);
        kw[i] = pk2(k0, k1); vw[i] = (unsigned)vp[(size_t)(2 * i) * 512] | ((unsigned)vp[(size_t)(2 * i + 1) * 512] << 16); }
    *(LAS u32x4*)(KT + d * 72 + 16 * seg) = (u32x4){kw[0], kw[1], kw[2], kw[3]}; *(LAS u32x4*)(KT + d * 72 + 16 * seg + 8) = (u32x4){kw[4], kw[5], kw[6], kw[7]};
    *(LAS u32x4*)(VT + d * 72 + 16 * seg) = (u32x4){vw[0], vw[1], vw[2], vw[3]}; *(LAS u32x4*)(VT + d * 72 + 16 * seg + 8) = (u32x4){vw[4], vw[5], vw[6], vw[7]};
    if (seg == 0) c.DEC()[(size_t)u * 128 + d] = __expf(bend);
    __syncthreads();
    const LAS bf16_t* ap = VT + (16 * wave + fr) * 72 + 8 * fq;
    const bf16x8 a0 = *(const LAS bf16x8*)ap, a1 = *(const LAS bf16x8*)(ap + 32);
    float* dst = c.DST() + (size_t)u * 16384;
#pragma unroll
    for (int nt = 0; nt < 8; ++nt) { const LAS bf16_t* bp = KT + (16 * nt + fr) * 72 + 8 * fq;
        const bf16x8 b0 = *(const LAS bf16x8*)bp, b1 = *(const LAS bf16x8*)(bp + 32);
        f32x4 a = {0.f, 0.f, 0.f, 0.f}; a = MFMA16(a0, b0, a); a = MFMA16(a1, b1, a);
#pragma unroll
        for (int i = 0; i < 4; ++i) dst[(16 * wave + 4 * fq + i) * 128 + 16 * nt + fr] = a[i]; }
}
DI void hg_scan(const Ctx& c, float* ps_l, int gtid, int gthreads) {
    for (int it = gtid; it < 16 * 8192; it += gthreads) {
        const int bh = it >> 13, ed2 = it & 8191, e = ed2 >> 6, d = (ed2 & 63) * 2;
        f32x2 S = {0.f, 0.f};
        const float* dp = c.DST() + (size_t)(bh * 64) * 16384 + e * 128 + d;
        const float* qp = c.DEC() + (size_t)(bh * 64) * 128 + d;
        bf16_t* sp = c.SB() + (size_t)(bh * 64) * 16384 + e * 128 + d;
#pragma unroll 8
        for (int cc = 0; cc < 64; ++cc) { const f32x2 ds = *(const f32x2*)(dp + (size_t)cc * 16384), dc = *(const f32x2*)(qp + (size_t)cc * 128);
            *(unsigned*)(sp + (size_t)cc * 16384) = pk2(S[0], S[1]); S = dc * S + ds; }
        ps_l[(size_t)bh * 16384 + d * 128 + e] = S[0]; ps_l[(size_t)bh * 16384 + (d + 1) * 128 + e] = S[1];
    }
}
DI void hg_pass3_unit(const Ctx& c, const float* normw_l, int u, LAS unsigned char* lds, int tid) {
    const int wave = tid >> 6, lane = tid & 63, fr = lane & 15, fq = lane >> 4;
    const int bh = u >> 6, ci = u & 63, bb = bh >> 2, h = bh & 3, r0 = bb * 4096 + 64 * ci;
    LAS bf16_t* QS = (LAS bf16_t*)lds;
    LAS bf16_t* QM = QS + 64 * 136;
    LAS bf16_t* KM = QM + 64 * 136;
    LAS bf16_t* VT = KM + 64 * 136;
    LAS bf16_t* ATT = VT + 128 * 72;
    LAS float* segtot = (LAS float*)(ATT + 64 * 72);
    LAS float* ssq = segtot + 512;
    const int d = tid & 127, seg = tid >> 7;
    __syncthreads();
    float bcs[16], bend, bmid; hg_cumsum(c.LOGF(), r0, h, d, seg, segtot, bcs, bend, bmid);
    {
        const bf16_t* qp = c.HQ() + (size_t)(r0 + 16 * seg) * 512 + h * 128 + d;
        const bf16_t* kp = c.HK() + (size_t)(r0 + 16 * seg) * 512 + h * 128 + d;
        const bf16_t* vp = c.HV() + (size_t)(r0 + 16 * seg) * 512 + h * 128 + d;
        unsigned vw[8];
#pragma unroll
        for (int i = 0; i < 16; ++i) { const int t = 16 * seg + i; const float q = bf2f(qp[(size_t)i * 512]), k = bf2f(kp[(size_t)i * 512]);
            QS[t * 136 + d] = f2bf(q * __expf(bcs[i])); QM[t * 136 + d] = f2bf(q * __expf(bcs[i] - bmid)); KM[t * 136 + d] = f2bf(k * __expf(bmid - bcs[i])); }
#pragma unroll
        for (int i = 0; i < 8; ++i) vw[i] = (unsigned)vp[(size_t)(2 * i) * 512] | ((unsigned)vp[(size_t)(2 * i + 1) * 512] << 16);
        *(LAS u32x4*)(VT + d * 72 + 16 * seg) = (u32x4){vw[0], vw[1], vw[2], vw[3]}; *(LAS u32x4*)(VT + d * 72 + 16 * seg + 8) = (u32x4){vw[4], vw[5], vw[6], vw[7]};
    }
    __syncthreads();
    {
        const int mt = wave >> 1;
        bf16x8 af[4];
#pragma unroll
        for (int kk = 0; kk < 4; ++kk) af[kk] = *(const LAS bf16x8*)(QM + (16 * mt + fr) * 136 + 32 * kk + 8 * fq);
#pragma unroll
        for (int n2 = 0; n2 < 2; ++n2) { const int nt = (wave & 1) * 2 + n2; f32x4 a = {0.f, 0.f, 0.f, 0.f};
#pragma unroll
            for (int kk = 0; kk < 4; ++kk) a = MFMA16(af[kk], *(const LAS bf16x8*)(KM + (16 * nt + fr) * 136 + 32 * kk + 8 * fq), a);
#pragma unroll
            for (int i = 0; i < 4; ++i) { const int t = 16 * mt + 4 * fq + i, s = 16 * nt + fr; ATT[t * 72 + s] = f2bf(s <= t ? a[i] : 0.f); } }
    }
    __syncthreads();
    const int tt = wave & 3, eh = wave >> 2;
    bf16x8 qs[4], at[2];
#pragma unroll
    for (int kk = 0; kk < 4; ++kk) qs[kk] = *(const LAS bf16x8*)(QS + (16 * tt + fr) * 136 + 32 * kk + 8 * fq);
#pragma unroll
    for (int kk = 0; kk < 2; ++kk) at[kk] = *(const LAS bf16x8*)(ATT + (16 * tt + fr) * 72 + 32 * kk + 8 * fq);
    f32x4 o[4]; float ss = 0.f;
    const bf16_t* sb = c.SB() + (size_t)u * 16384;
#pragma unroll
    for (int j = 0; j < 4; ++j) { const int et = 4 * eh + j; f32x4 a = {0.f, 0.f, 0.f, 0.f};
#pragma unroll
        for (int kk = 0; kk < 4; ++kk) a = MFMA16(*(const bf16x8*)(sb + (16 * et + fr) * 128 + 32 * kk + 8 * fq), qs[kk], a);
#pragma unroll
        for (int kk = 0; kk < 2; ++kk) a = MFMA16(*(const LAS bf16x8*)(VT + (16 * et + fr) * 72 + 32 * kk + 8 * fq), at[kk], a);
        o[j] = a; ss += (a[0] * a[0] + a[1] * a[1]) + (a[2] * a[2] + a[3] * a[3]); }
    ss += __shfl_xor(ss, 16); ss += __shfl_xor(ss, 32);
    if (fq == 0) ssq[eh * 64 + 16 * tt + fr] = ss;
    __syncthreads();
    const float rinv = rsqrtf((ssq[16 * tt + fr] + ssq[64 + 16 * tt + fr]) * (1.f / 128.f) + RMS_EPS);
    const size_t row = (size_t)(r0 + 16 * tt + fr);
#pragma unroll
    for (int j = 0; j < 4; ++j) { const int e0 = 16 * (4 * eh + j) + 4 * fq;
        const u32x2 hw = *(const u32x2*)(c.HG() + row * 512 + h * 128 + e0); const f32x4 nw = *(const f32x4*)(normw_l + e0);
        const float r0_ = o[j][0] * rinv * nw[0] * bflo(hw.x), r1_ = o[j][1] * rinv * nw[1] * bfhi(hw.x), r2_ = o[j][2] * rinv * nw[2] * bflo(hw.y), r3_ = o[j][3] * rinv * nw[3] * bfhi(hw.y);
        u32x2 w; w.x = pk2(r0_, r1_); w.y = pk2(r2_, r3_); *(u32x2*)(c.AH() + row * 1024 + 512 + h * 128 + e0) = w; }
}
DI void hg_sample_unit(const Ctx& c, const float* normw_l, int l, int u, LAS unsigned char* lds, int tid) {
    const int wave = tid >> 6, lane = tid & 63;
    const int bs = u >> 2, h = u & 3;
    LAS float* red = (LAS float*)lds;
    LAS float* ssq = red + 4 * 16 * 128;
    const int dg = tid >> 5, e4 = (tid & 31) * 4;
    const float* sp = c.in(I_ST) + ((size_t)((l * 128 + bs) * 4 + h)) * 16384;
    float* so = c.out() + O_SS + ((size_t)((l * 128 + bs) * 4 + h)) * 16384;
    __syncthreads();
    f32x4 S[8];
#pragma unroll
    for (int dd = 0; dd < 8; ++dd) S[dd] = *(const f32x4*)(sp + (dg * 8 + dd) * 128 + e4);
#pragma unroll
    for (int t = 0; t < 4; ++t) { const size_t row = (size_t)(MP + bs * 4 + t);
        const u32x2 vw = *(const u32x2*)(c.HV() + row * 512 + h * 128 + e4); const f32x4 v = {bflo(vw.x), bfhi(vw.x), bflo(vw.y), bfhi(vw.y)};
        f32x4 po = {0.f, 0.f, 0.f, 0.f};
#pragma unroll
        for (int dd = 0; dd < 8; ++dd) { const size_t ix = row * 512 + h * 128 + dg * 8 + dd;
            const float f = __expf(c.LOGF()[ix]), k = bf2f(c.HK()[ix]), q = bf2f(c.HQ()[ix]);
            S[dd] = S[dd] * f + v * k; po = po + S[dd] * q; }
        *(LAS f32x4*)(red + (t * 16 + dg) * 128 + e4) = po; }
#pragma unroll
    for (int dd = 0; dd < 8; ++dd) *(f32x4*)(so + (dg * 8 + dd) * 128 + e4) = S[dd];
    __syncthreads();
    const int t = tid >> 7, e = tid & 127;
    float o = 0.f;
#pragma unroll
    for (int g = 0; g < 16; ++g) o += red[(t * 16 + g) * 128 + e];
    const float ss = wave_sum(o * o);
    if (lane == 0) ssq[wave] = ss;
    __syncthreads();
    const float rinv = rsqrtf((ssq[wave & ~1] + ssq[(wave & ~1) + 1]) * (1.f / 128.f) + RMS_EPS);
    const size_t row = (size_t)(MP + bs * 4 + t);
    c.AH()[row * 1024 + 512 + h * 128 + e] = f2bf(o * rinv * normw_l[e] * bf2f(c.HG()[row * 512 + h * 128 + e]));
}

#define OPQ_S(x) ({ int s_ = (x); asm volatile("" : "+s"(s_)); s_; })
#define OPAQUE_TID() ({ int t_ = threadIdx.x; asm volatile("" : "+v"(t_)); t_; })
#ifndef PHM
#define PHM 0xFFFFF
#endif
__global__ void __launch_bounds__(NTHREADS, 2) hybrid_fwd(Params p) {
    extern __shared__ __attribute__((aligned(16))) unsigned char lds_raw[];
    LAS unsigned char* lds = (LAS unsigned char*)lds_raw;
    cg::grid_group grid = cg::this_grid();
    const int tid = threadIdx.x, lane = tid & 63, wave = __builtin_amdgcn_readfirstlane(tid >> 6);
    const int G = gridDim.x, bid = blockIdx.x;
    const int gw = bid * NWAVES + wave, ngw = G * NWAVES;
    Ctx c; c.lds0 = lds;
    if (tid == 0) { LAS unsigned long long* w = (LAS unsigned long long*)(lds + PARAM_LDS_OFF);
        w[0] = (unsigned long long)p.x_prompt; w[1] = (unsigned long long)p.x_sample; w[2] = (unsigned long long)p.cache_k; w[3] = (unsigned long long)p.cache_v; w[4] = (unsigned long long)p.state;
        w[5] = (unsigned long long)p.w_in; w[6] = (unsigned long long)p.b_gate; w[7] = (unsigned long long)p.sink; w[8] = (unsigned long long)p.lb_logits; w[9] = (unsigned long long)p.norm_w;
        w[10] = (unsigned long long)p.w_upa; w[11] = (unsigned long long)p.w_uph; w[12] = (unsigned long long)p.w_out; w[13] = (unsigned long long)p.ln1g; w[14] = (unsigned long long)p.ln1b;
        w[15] = (unsigned long long)p.w_ff1; w[16] = (unsigned long long)p.w_ff2; w[17] = (unsigned long long)p.ln2g; w[18] = (unsigned long long)p.ln2b; w[19] = (unsigned long long)p.out; w[20] = (unsigned long long)p.ws; }
    __syncthreads();

    if (PHM & 1) convert_layer(c, 0, lds, gw, ngw, wave, lane);
    if (PHM & 1) for (int m = gw; m < MT; m += ngw) {
        const float* src = m < MP ? c.in(I_XP) + (size_t)m * DM : c.in(I_XS) + (size_t)(m - MP) * DM;
        ln_row(src, nullptr, nullptr, c.X() + (size_t)m * DM, c.XB() + (size_t)m * DM, nullptr, lane, false);
    }
    if (bid == 0) {
        const int d = tid;
        float z[4], mx = -3.0e38f;
#pragma unroll
        for (int l = 0; l < 4; ++l) { z[l] = c.in(I_LB)[l * 512 + d]; mx = fmaxf(mx, z[l]); }
        float s = 0.f;
#pragma unroll
        for (int l = 0; l < 4; ++l) { z[l] = expf(z[l] - mx); s += z[l]; }
        float cum = 0.f;
#pragma unroll
        for (int l = 0; l < 4; ++l) { const float lb = cum; cum += (l + 1 < 4) ? z[l + 1] / s : 0.f;
            float* o = c.LBT() + ((size_t)l * 512 + d) * 4; o[0] = lb; o[1] = logf(fmaxf(lb, 1e-30f)); o[2] = log1pf(-lb); o[3] = 0.f; }
    }
    grid.sync();

#pragma unroll 1
    for (int l = 0; l < DEPTH; ++l) {
        if (PHM & 2) {
            pg8::Gemm g{c.XB(), c.WIN(), MT, NIN, DM, DM, DM}; pg8::StaticOrder S; S.init(MT, NIN, OPQ_S(gridDim.x), OPQ_S(blockIdx.x));
            Epi1 E{c.AQ(), c.AK(), c.AV(), c.HQ(), c.HK(), c.HV(), c.HG(), c.G(), c.LOGF(), c.LBT() + (size_t)l * 2048, c.in(I_BG) + l * 2048,
                   c.out() + O_PK + (size_t)l * 65536, c.out() + O_PV + (size_t)l * 65536, c.out() + O_SK + (size_t)l * 2097152, c.out() + O_SV + (size_t)l * 2097152};
            pg8::gemm_phase<Epi1, pg8::StaticOrder, true, true>(lds, g, S, E);
        }
        grid.sync();
        for (int it = OPQ_S(blockIdx.x), G_ = OPQ_S(gridDim.x); it < 2048; it += G_) {
            if (it < 256) { if (PHM & 4) attn_prompt_unit(c, c.in(I_SINK) + l * 8, it, lds, OPAQUE_TID()); }
            else if (it < 512) { if (PHM & 8) attn_sample_unit(c, c.in(I_SINK) + l * 8, l, it - 256, lds, OPAQUE_TID()); }
            else if (it < 1536) { if (PHM & 16) hg_pass1_unit(c, it - 512, lds, OPAQUE_TID()); }
            else { if (PHM & 32) hg_sample_unit(c, c.in(I_NW) + l * 128, l, it - 1536, lds, OPAQUE_TID()); }
        }
        grid.sync();
        if (PHM & 64) hg_scan(c, c.out() + O_PS + (size_t)l * 262144, OPQ_S(blockIdx.x) * NTHREADS + OPAQUE_TID(), OPQ_S(gridDim.x) * NTHREADS);
        grid.sync();
        if (PHM & 128) for (int it = OPQ_S(blockIdx.x), G_ = OPQ_S(gridDim.x); it < 1024; it += G_) hg_pass3_unit(c, c.in(I_NW) + l * 128, it, lds, OPAQUE_TID());
        grid.sync();
        if (PHM & 256) {
            pg8::StaticOrder S; S.init(MT, DM, OPQ_S(gridDim.x), OPQ_S(blockIdx.x));
            { pg8::Gemm g{c.AH(), c.WUP(), MT, DM, 512, DM, DM}; EpiUp1 E{c.G(), c.Y()}; pg8::gemm_phase<EpiUp1, pg8::StaticOrder, true, true>(lds, g, S, E); }
            __syncthreads();
            { pg8::Gemm g{c.AH() + 512, c.WUP() + 512, MT, DM, 512, DM, DM}; EpiUp2 E{c.G(), c.Y(), c.MG()}; pg8::gemm_phase<EpiUp2, pg8::StaticOrder, true, true>(lds, g, S, E); }
        }
        grid.sync();
        if (PHM & 512) {
            pg8::Gemm g{c.MG(), c.WOUT(), MT, DM, DM, DM, DM}; pg8::StaticOrder S; S.init(MT, DM, OPQ_S(gridDim.x), OPQ_S(blockIdx.x));
            EpiRes E{c.X(), c.Y()}; pg8::gemm_phase<EpiRes, pg8::StaticOrder, true, true>(lds, g, S, E);
        }
        grid.sync();
        if (PHM & 4096) for (int m = OPQ_S(gw), ngw_ = OPQ_S(ngw); m < MT; m += ngw_) ln_row(c.Y() + (size_t)m * DM, c.in(I_L1G) + l * DM, c.in(I_L1B) + l * DM, c.X() + (size_t)m * DM, c.XB() + (size_t)m * DM, nullptr, OPAQUE_TID() & 63, true);
        grid.sync();
        if (PHM & 1024) {
            pg8::Gemm g{c.XB(), c.WFF1(), MT, FF, DM, DM, DM}; pg8::StaticOrder S; S.init(MT, FF, OPQ_S(gridDim.x), OPQ_S(blockIdx.x));
            EpiRelu2 E{c.HB()}; pg8::gemm_phase<EpiRelu2, pg8::StaticOrder, true, true>(lds, g, S, E);
        }
        grid.sync();
        if (PHM & 2048) {
            pg8::Gemm g{c.HB(), c.WFF2(), MT, DM, FF, FF, FF}; pg8::StaticOrder S; S.init(MT, DM, OPQ_S(gridDim.x), OPQ_S(blockIdx.x));
            EpiRes E{c.X(), c.Y()}; pg8::gemm_phase<EpiRes, pg8::StaticOrder, true, true>(lds, g, S, E);
        }
        grid.sync();
        if (PHM & 4096) for (int m = OPQ_S(gw), ngw_ = OPQ_S(ngw); m < MT; m += ngw_) ln_row(c.Y() + (size_t)m * DM, c.in(I_L2G) + l * DM, c.in(I_L2B) + l * DM, c.X() + (size_t)m * DM, c.XB() + (size_t)m * DM,
                                                 l == DEPTH - 1 ? c.out() + O_Y + (size_t)m * DM : nullptr, OPAQUE_TID() & 63, true);
        if ((PHM & 1) && l + 1 < DEPTH) convert_layer(c, l + 1, lds, OPQ_S(gw), OPQ_S(ngw), wave, OPAQUE_TID() & 63);
        grid.sync();
    }
}

extern "C" void kernel_launch(void* const* d_in, const int* in_sizes, int n_in, void* d_out, int out_size, void* d_ws, size_t ws_size, hipStream_t stream) {
    static int grid = 0;
    if (grid == 0) {
        if (n_in != 19 || ws_size < WS_END) { fprintf(stderr, "kernel_launch: unexpected inputs (n_in %d, ws %zu, need %zu)\n", n_in, ws_size, (size_t)WS_END); grid = -1; return; }
        int dev = 0, cus = 0, per_cu = 0;
        hipGetDevice(&dev); hipDeviceGetAttribute(&cus, hipDeviceAttributeMultiprocessorCount, dev);
        hipFuncSetAttribute((const void*)hybrid_fwd, hipFuncAttributeMaxDynamicSharedMemorySize, LDS_BYTES);
        if (hipOccupancyMaxActiveBlocksPerMultiprocessor(&per_cu, (const void*)hybrid_fwd, NTHREADS, LDS_BYTES) != hipSuccess || per_cu < 1) { fprintf(stderr, "kernel_launch: occupancy query says %d\n", per_cu); per_cu = 1; }
        (void)hipGetLastError();
        grid = cus * 1;
        if (grid <= 0) grid = 256;
    }
    if (grid < 0) return;
    Params p{};
    p.x_prompt = (const float*)d_in[0]; p.x_sample = (const float*)d_in[1]; p.cache_k = (const float*)d_in[2]; p.cache_v = (const float*)d_in[3]; p.state = (const float*)d_in[4];
    p.w_in = (const float*)d_in[5]; p.b_gate = (const float*)d_in[6]; p.sink = (const float*)d_in[7]; p.lb_logits = (const float*)d_in[8]; p.norm_w = (const float*)d_in[9];
    p.w_upa = (const float*)d_in[10]; p.w_uph = (const float*)d_in[11]; p.w_out = (const float*)d_in[12]; p.ln1g = (const float*)d_in[13]; p.ln1b = (const float*)d_in[14];
    p.w_ff1 = (const float*)d_in[15]; p.w_ff2 = (const float*)d_in[16]; p.ln2g = (const float*)d_in[17]; p.ln2b = (const float*)d_in[18];
    p.out = (float*)d_out; p.ws = (unsigned char*)d_ws;
    void* args[] = {&p};
    hipError_t e = hipLaunchCooperativeKernel((const void*)hybrid_fwd, dim3(grid), dim3(NTHREADS), args, LDS_BYTES, stream);
    if (e != hipSuccess) fprintf(stderr, "kernel_launch: cooperative launch failed: %s (grid %d)\n", hipGetErrorString(e), grid);
}
```

```cpp
#include <hip/hip_runtime.h>
#include <hip/hip_cooperative_groups.h>
#include <cstdio>
#include <cstdint>
namespace cg = cooperative_groups;
namespace pg8 {
#define PG8_LAS __attribute__((address_space(3)))
typedef unsigned short bf16_t;
typedef short bf16x8 __attribute__((ext_vector_type(8)));
typedef float f32x4 __attribute__((ext_vector_type(4)));
typedef unsigned u32x4 __attribute__((ext_vector_type(4)));
constexpr int BM = 256, BK = 64, HALF = 128, HTB = HALF * BK * 2  , STAGE_BYTES = 8 * HTB, NXCD = 8, WGM = 8;

__host__ __device__ __forceinline__ int lds_byte(int r, int c) { const int st = (r >> 4) * 2 + (c >> 5), rr = r & 15, cc = c & 31, ob = rr * 64 + cc * 2; return st * 1024 + (ob ^ (((ob >> 9) & 1) << 5)); }
__host__ __device__ __forceinline__ void stage_rc(int b, int& R, int& C) { const int st = b / 1024, sb = b % 1024, swz = sb ^ (((sb >> 9) & 1) << 5); R = (st >> 1) * 16 + swz / 64; C = (st & 1) * 32 + (swz % 64) / 2; }
__host__ __device__ __forceinline__ int perm32(int rho) { const int n = rho >> 4, i = rho & 15; return 8 * (i >> 2) + 4 * n + (i & 3); }

struct Unit { int pm, pn; };
struct Gemm { const bf16_t* A; const bf16_t* Bt; int M, N, K, lda, ldb; };

struct StaticOrder {
    int nM, nN, nwg, G, c;
    __host__ __device__ void init(int M, int N, int G_, int c_) { nM = M / BM; nN = N / BM; nwg = nM * nN; G = G_; c = c_; }
    __host__ __device__ bool next(int i, Unit& u) const {
        const long L = (long)i * G + c; if (L >= nwg) return false;
        int wgid = (int)L; { const int q = nwg / NXCD, r = nwg % NXCD, xcd = wgid % NXCD, off = wgid / NXCD; wgid = (xcd < r ? xcd * (q + 1) : r * (q + 1) + (xcd - r) * q) + off; }
        const int nig = WGM * nN, gid = wgid / nig, fm = gid * WGM, gsz = (nM - fm) < WGM ? (nM - fm) : WGM;
        u.pm = fm + ((wgid % nig) % gsz); u.pn = (wgid % nig) / gsz; return true;
    }
    __device__ __forceinline__ void a_ready(const Unit&) const {}
    __device__ __forceinline__ void done(const Unit&) const {}
};

template <class Epi, class Sched, bool ALIGN_EPI = false, bool SP2 = false>
__device__ __forceinline__ void gemm_phase(PG8_LAS unsigned char* lds, const Gemm g, const Sched& S, const Epi& E) {
    int tid_op = threadIdx.x; asm volatile("" : "+v"(tid_op));
    const int tid = tid_op, wid = __builtin_amdgcn_readfirstlane(tid >> 6), lane = tid & 63, wr = wid >> 2, wc = wid & 3, fr = lane & 15, fq = lane >> 4;
    const int K = g.K, nt = K / BK;
    unsigned voffA[2], voffB[2];
#pragma unroll
    for (int i = 0; i < 2; ++i) { int R, C; stage_rc(tid * 16 + i * 8192, R, C); const int Rb = Epi::PERM ? ((R & ~31) + perm32(R & 31)) : R;
        voffA[i] = (unsigned)(R * g.lda + C) * 2u; voffB[i] = (unsigned)(Rb * g.ldb + C) * 2u; }
    const size_t kstep = (size_t)(BK * 2);
    const size_t hstepA = (size_t)HALF * g.lda * 2, hstepB = (size_t)HALF * g.ldb * 2;
    const size_t tstepA = 2 * hstepA, tstepB = 2 * hstepB;
    const unsigned ldsw = (unsigned)wid * 1024u;
    const int aoff = lds_byte(wr * 64 + fr, fq * 8), boff = lds_byte(wc * 32 + fr, fq * 8);
#define PG8_SA(b, h) (((b) * 2 + (h)) * HTB)
#define PG8_SB(b, h) ((4 + (b) * 2 + (h)) * HTB)
#define PG8_STAGE(bufoff, gbase, voff) do { _Pragma("unroll") for (int _i = 0; _i < 2; ++_i) \
        __builtin_amdgcn_global_load_lds((const unsigned*)((const char*)(gbase) + (voff)[_i]), (PG8_LAS unsigned*)(lds + (bufoff) + ldsw + _i * 8192), 16, 0, 0); } while (0)
#define PG8_LDA(dst, b, h) do { _Pragma("unroll") for (int m = 0; m < 4; ++m) _Pragma("unroll") for (int k = 0; k < 2; ++k) dst[m][k] = *(const PG8_LAS bf16x8*)(lds + PG8_SA(b, h) + aoff + m * 2048 + k * 1024); } while (0)
#define PG8_LDB(dst, b, h) do { _Pragma("unroll") for (int n = 0; n < 2; ++n) _Pragma("unroll") for (int k = 0; k < 2; ++k) dst[n][k] = *(const PG8_LAS bf16x8*)(lds + PG8_SB(b, h) + boff + n * 2048 + k * 1024); } while (0)
#define PG8_MMA(ai, bj, At, Bt) do { __builtin_amdgcn_s_setprio(1); _Pragma("unroll") for (int m = 0; m < 4; ++m) _Pragma("unroll") for (int n = 0; n < 2; ++n) _Pragma("unroll") for (int k = 0; k < 2; ++k) \
        acc[ai][bj][m][n] = __builtin_amdgcn_mfma_f32_16x16x32_bf16(Bt[n][k], At[m][k], acc[ai][bj][m][n], 0, 0, 0); __builtin_amdgcn_s_setprio(0); } while (0)
#define PG8_WAIT_V(n) asm volatile("s_waitcnt vmcnt(" #n ")" ::: "memory")
#define PG8_WAIT_L(n) asm volatile("s_waitcnt lgkmcnt(" #n ")" ::: "memory")
#define PG8_BAR __builtin_amdgcn_s_barrier()
#define PG8_SCHED __builtin_amdgcn_sched_barrier(0)
    Unit cur, nxt; int ui = 0;
    if (!S.next(0, cur)) return;
    f32x4 acc[2][2][4][2];
#pragma unroll
    for (int a = 0; a < 2; ++a)
#pragma unroll
        for (int b = 0; b < 2; ++b)
#pragma unroll
            for (int m = 0; m < 4; ++m)
#pragma unroll
                for (int n = 0; n < 2; ++n) acc[a][b][m][n] = (f32x4){0.f, 0.f, 0.f, 0.f};
    bf16x8 At[4][2], B0[2][2], B1[2][2];
    const char* cA = (const char*)g.A + (size_t)cur.pm * tstepA; const char* cB = (const char*)g.Bt + (size_t)cur.pn * tstepB;
    S.a_ready(cur);
    if constexpr (SP2) {
        PG8_STAGE(PG8_SB(0, 0), cB, voffB); PG8_STAGE(PG8_SB(0, 1), cB + hstepB, voffB); PG8_STAGE(PG8_SA(0, 0), cA, voffA); PG8_STAGE(PG8_SA(0, 1), cA + hstepA, voffA);
        if (wr == 1) PG8_BAR;
        PG8_WAIT_V(2); PG8_BAR;
        PG8_STAGE(PG8_SB(1, 0), cB + kstep, voffB); PG8_STAGE(PG8_SA(1, 0), cA + kstep, voffA); PG8_STAGE(PG8_SB(1, 1), cB + hstepB + kstep, voffB);
        PG8_WAIT_V(6); PG8_BAR;
    } else {
        PG8_STAGE(PG8_SB(0, 0), cB, voffB); PG8_STAGE(PG8_SA(0, 0), cA, voffA); PG8_STAGE(PG8_SB(0, 1), cB + hstepB, voffB); PG8_STAGE(PG8_SA(0, 1), cA + hstepA, voffA);
        if (wr == 1) PG8_BAR;
        PG8_WAIT_V(4); PG8_BAR;
        PG8_STAGE(PG8_SB(1, 0), cB + kstep, voffB); PG8_STAGE(PG8_SA(1, 0), cA + kstep, voffA); PG8_STAGE(PG8_SB(1, 1), cB + hstepB + kstep, voffB);
        PG8_WAIT_V(6); PG8_BAR;
    }
    for (;;) {
        const bool has_next = S.next(ui + 1, nxt);
        const char* nA = has_next ? (const char*)g.A + (size_t)nxt.pm * tstepA : cA; const char* nB = has_next ? (const char*)g.Bt + (size_t)nxt.pn * tstepB : cB;
        for (int t = 0; t < nt; t += 2) {
            const bool last = (t == nt - 2);
            const char* a1 = cA + (size_t)(t + 1) * kstep;
            const char* a2 = last ? nA : cA + (size_t)(t + 2) * kstep; const char* b2 = last ? nB : cB + (size_t)(t + 2) * kstep;
            const char* a3 = a2 + kstep; const char* b3 = b2 + kstep;
            if (last && has_next) S.a_ready(nxt);
            if constexpr (SP2) {
            PG8_LDB(B0, 0, 0); PG8_LDB(B1, 0, 1); PG8_SCHED; PG8_LDA(At, 0, 0); PG8_STAGE(PG8_SA(1, 1), a1 + hstepA, voffA);
            PG8_WAIT_V(8); PG8_WAIT_L(0); PG8_BAR; PG8_MMA(0, 0, At, B0); PG8_MMA(0, 1, At, B1); PG8_BAR; PG8_SCHED;
            PG8_LDA(At, 0, 1); PG8_STAGE(PG8_SB(0, 0), b2, voffB); PG8_STAGE(PG8_SB(0, 1), b2 + hstepB, voffB); PG8_STAGE(PG8_SA(0, 0), a2, voffA);
            PG8_WAIT_V(8); PG8_WAIT_L(0); PG8_BAR; PG8_MMA(1, 0, At, B0); PG8_MMA(1, 1, At, B1); PG8_BAR; PG8_SCHED;
            PG8_LDB(B0, 1, 0); PG8_LDB(B1, 1, 1); PG8_SCHED; PG8_LDA(At, 1, 0); PG8_STAGE(PG8_SA(0, 1), a2 + hstepA, voffA);
            PG8_WAIT_V(8); PG8_WAIT_L(0); PG8_BAR; PG8_MMA(0, 0, At, B0); PG8_MMA(0, 1, At, B1); PG8_BAR; PG8_SCHED;
            PG8_LDA(At, 1, 1); PG8_STAGE(PG8_SB(1, 0), b3, voffB); PG8_STAGE(PG8_SB(1, 1), b3 + hstepB, voffB); PG8_STAGE(PG8_SA(1, 0), a3, voffA);
            PG8_WAIT_V(8); PG8_WAIT_L(0); PG8_BAR; PG8_MMA(1, 0, At, B0); PG8_MMA(1, 1, At, B1); PG8_BAR; PG8_SCHED;
            } else {
            PG8_LDB(B0, 0, 0); PG8_SCHED; PG8_LDA(At, 0, 0); PG8_STAGE(PG8_SA(1, 1), a1 + hstepA, voffA);
            PG8_WAIT_L(8); PG8_BAR; PG8_WAIT_L(0); PG8_MMA(0, 0, At, B0); PG8_BAR; PG8_SCHED;
            PG8_LDB(B1, 0, 1); PG8_STAGE(PG8_SB(0, 0), b2, voffB);
            PG8_BAR; PG8_WAIT_L(0); PG8_MMA(0, 1, At, B1); PG8_BAR;
            PG8_LDA(At, 0, 1); PG8_STAGE(PG8_SA(0, 0), a2, voffA);
            PG8_BAR; PG8_WAIT_L(0); PG8_MMA(1, 0, At, B0); PG8_BAR; PG8_SCHED;
            PG8_STAGE(PG8_SB(0, 1), b2 + hstepB, voffB);
            PG8_WAIT_V(6); PG8_BAR; PG8_MMA(1, 1, At, B1); PG8_BAR;
            PG8_LDB(B0, 1, 0); PG8_SCHED; PG8_LDA(At, 1, 0); PG8_STAGE(PG8_SA(0, 1), a2 + hstepA, voffA);
            PG8_WAIT_L(8); PG8_BAR; PG8_WAIT_L(0); PG8_MMA(0, 0, At, B0); PG8_BAR; PG8_SCHED;
            PG8_LDB(B1, 1, 1); PG8_STAGE(PG8_SB(1, 0), b3, voffB);
            PG8_BAR; PG8_WAIT_L(0); PG8_MMA(0, 1, At, B1); PG8_BAR;
            PG8_LDA(At, 1, 1); PG8_STAGE(PG8_SA(1, 0), a3, voffA);
            PG8_BAR; PG8_WAIT_L(0); PG8_MMA(1, 0, At, B0); PG8_BAR; PG8_SCHED;
            PG8_STAGE(PG8_SB(1, 1), b3 + hstepB, voffB);
            PG8_WAIT_V(6); PG8_BAR; PG8_MMA(1, 1, At, B1); PG8_BAR;
            }
        }
        if constexpr (ALIGN_EPI) { if (wr == 0) PG8_BAR; }
        if constexpr (!Epi::AFTER_DRAIN) { E(acc, cur, wr, wc, fr, fq); S.done(cur); }
        if (!has_next) break;
#pragma unroll
        for (int a = 0; a < 2; ++a)
#pragma unroll
            for (int b = 0; b < 2; ++b)
#pragma unroll
                for (int m = 0; m < 4; ++m)
#pragma unroll
                    for (int n = 0; n < 2; ++n) acc[a][b][m][n] = (f32x4){0.f, 0.f, 0.f, 0.f};
        cur = nxt; cA = nA; cB = nB; ++ui;
        if constexpr (ALIGN_EPI) { if (wr == 1) PG8_BAR; }
    }
    PG8_WAIT_V(0);
    if constexpr (!ALIGN_EPI) { if (wr == 0) PG8_BAR; }
    PG8_BAR;
    if constexpr (Epi::AFTER_DRAIN) { E.fused(acc, cur, wr, wc, fr, fq, lds, wid, lane); S.done(cur); }
#undef PG8_SA
#undef PG8_SB
#undef PG8_STAGE
#undef PG8_LDA
#undef PG8_LDB
#undef PG8_MMA
#undef PG8_WAIT_V
#undef PG8_WAIT_L
#undef PG8_BAR
#undef PG8_SCHED
}
}


#define DI __device__ __forceinline__
#define LAS __attribute__((address_space(3)))
using pg8::bf16_t; using pg8::bf16x8; using pg8::f32x4; using pg8::u32x4;
typedef float f32x2 __attribute__((ext_vector_type(2)));
typedef unsigned u32x2 __attribute__((ext_vector_type(2)));
typedef __bf16 bf2_t __attribute__((ext_vector_type(2)));

constexpr int MP = 16384, MS = 512, MT = MP + MS;
constexpr int DM = 1024, NIN = 4864, FF = 4096, DEPTH = 4;
constexpr float ALPHA = 1.681792830507429f;
constexpr float LN_EPS = 1e-5f, RMS_EPS = 1e-6f;
constexpr int NWAVES = 8, NTHREADS = 512;
constexpr int LDS_BYTES = 147456;

constexpr size_t O_Y = 0, O_PK = (size_t)MT * DM, O_PV = O_PK + 262144, O_PS = O_PV + 262144, O_SK = O_PS + 1048576, O_SV = O_SK + 8388608, O_SS = O_SV + 8388608;

constexpr size_t MiB = 1u << 20;
constexpr size_t WS_LBT = 0;
constexpr size_t WS_WIN = 1 * MiB, WS_WUP = 11 * MiB, WS_WOUT = 13 * MiB, WS_WFF1 = 15 * MiB, WS_WFF2 = 23 * MiB;
constexpr size_t WS_X = 31 * MiB;
constexpr size_t WS_XB = 97 * MiB;
constexpr size_t WS_G = 130 * MiB;
constexpr size_t WS_AH = 196 * MiB;
constexpr size_t WS_R = 229 * MiB;
constexpr size_t WS_HB = WS_R;
constexpr size_t WS_Y = WS_R + 132 * MiB;
constexpr size_t WS_MG = WS_R;
constexpr size_t WS_LOGF = WS_R + 34 * MiB;
constexpr size_t WS_HQ = WS_R + 67 * MiB, WS_HK = WS_R + 84 * MiB, WS_HV = WS_R + 101 * MiB, WS_HG = WS_R + 118 * MiB;
constexpr size_t WS_DST = WS_R + 135 * MiB;
constexpr size_t WS_SB = WS_R + 199 * MiB;
constexpr size_t WS_AQ = 460 * MiB;
constexpr size_t WS_AK = 477 * MiB, WS_AV = 482 * MiB;
constexpr size_t WS_DEC = 487 * MiB;
constexpr size_t WS_END = 488 * MiB;

struct Params {
    const float *x_prompt, *x_sample, *cache_k, *cache_v, *state, *w_in, *b_gate, *sink, *lb_logits, *norm_w, *w_upa, *w_uph, *w_out, *ln1g, *ln1b, *w_ff1, *w_ff2, *ln2g, *ln2b;
    float* out; unsigned char* ws;
};

DI unsigned pk2(float lo, float hi) { f32x2 v = {lo, hi}; bf2_t b = __builtin_convertvector(v, bf2_t); return __builtin_bit_cast(unsigned, b); }
DI bf16_t f2bf(float x) { return (bf16_t)(pk2(x, 0.f) & 0xffffu); }
DI float bf2f(bf16_t h) { return __uint_as_float((unsigned)h << 16); }
DI float bflo(unsigned w) { return __uint_as_float(w << 16); }
DI float bfhi(unsigned w) { return __uint_as_float(w & 0xffff0000u); }
DI void st_bf16x8(bf16_t* p, f32x4 a, f32x4 b) { u32x4 w; w.x = pk2(a[0], a[1]); w.y = pk2(a[2], a[3]); w.z = pk2(b[0], b[1]); w.w = pk2(b[2], b[3]); *(u32x4*)p = w; }
DI void ld_bf16x8(const bf16_t* p, f32x4& a, f32x4& b) { const u32x4 w = *(const u32x4*)p; a = (f32x4){bflo(w.x), bfhi(w.x), bflo(w.y), bfhi(w.y)}; b = (f32x4){bflo(w.z), bfhi(w.z), bflo(w.w), bfhi(w.w)}; }
DI float sigm(float x) { return 1.f / (1.f + __expf(-x)); }
DI float silu(float x) { return x / (1.f + __expf(-x)); }
DI float wave_sum(float v) {
#pragma unroll
    for (int o = 1; o < 64; o <<= 1) v += __shfl_xor(v, o);
    return v;
}
#define MFMA16(a, b, c) __builtin_amdgcn_mfma_f32_16x16x32_bf16((a), (b), (c), 0, 0, 0)
#define LDS_WAIT() asm volatile("s_waitcnt lgkmcnt(0)" ::: "memory")

#define EPI_ARGS const f32x4 (&acc)[2][2][4][2], const pg8::Unit& u, int wr, int wc, int fr, int fq
#define EPI_ROWS _Pragma("unroll") for (int ai = 0; ai < 2; ++ai) _Pragma("unroll") for (int m = 0; m < 4; ++m)
#define EPI_ROW (u.pm * 256 + ai * 128 + wr * 64 + m * 16 + fr)
#define EPI_COL(bj) (u.pn * 256 + (bj) * 128 + wc * 32 + 8 * fq)

struct Epi1 {
    static constexpr bool PERM = true, AFTER_DRAIN = false;
    bf16_t *AQ, *AK, *AV, *HQ, *HK, *HV, *HG, *G; float* LOGF; const float* LBT; const float* bgate; float *pk, *pv, *sk, *sv;
    template <int bj, int n> DI void hf_part(EPI_ARGS) const {
        const int d0 = EPI_COL(bj) - 1280 + 4 * n;
        f32x4 lb[4];
#pragma unroll
        for (int j = 0; j < 4; ++j) lb[j] = *(const f32x4*)(LBT + (size_t)(d0 + j) * 4);
        EPI_ROWS { const size_t row = EPI_ROW; f32x4 lo, ko;
#pragma unroll
            for (int j = 0; j < 4; ++j) { const float hf = acc[ai][bj][m][n][j]; const f32x4 L = lb[j];
                const float ls = fminf(hf, 0.f) - __logf(1.f + __expf(-fabsf(hf)));
                const float bb = L[2] + ls, mx = fmaxf(L[1], bb); lo[j] = mx + __logf(1.f + __expf(-fabsf(L[1] - bb)));
                ko[j] = (1.f - L[0]) / (1.f + __expf(hf)); }
            *(f32x4*)(LOGF + row * 512 + d0) = lo;
            u32x2 w; w.x = pk2(ko[0], ko[1]); w.y = pk2(ko[2], ko[3]); *(u32x2*)(HK + row * 512 + d0) = w;
            asm volatile("" ::: "memory"); }
    }
    DI void operator()(EPI_ARGS) const {
        const int pn = u.pn;
        if (pn < 2) {
            EPI_ROWS { const size_t row = EPI_ROW;
#pragma unroll
                for (int bj = 0; bj < 2; ++bj) st_bf16x8(AQ + row * 512 + EPI_COL(bj), acc[ai][bj][m][0] * 0.125f, acc[ai][bj][m][1] * 0.125f); }
        } else if (pn == 2) {
            EPI_ROWS { const int row = EPI_ROW;
#pragma unroll
                for (int bj = 0; bj < 2; ++bj) { const int lc = wc * 32 + 8 * fq; const f32x4 v0 = acc[ai][bj][m][0], v1 = acc[ai][bj][m][1];
                    st_bf16x8((bj == 0 ? AK : AV) + (size_t)row * 128 + lc, v0, v1);
                    float* o = nullptr;
                    if (row < MP) { const int t = row & 4095, b = row >> 12; if (t >= 3968) o = (bj == 0 ? pk : pv) + (size_t)(b * 128 + t - 3968) * 128 + lc; }
                    else { const int r = row - MP; o = (bj == 0 ? sk : sv) + (size_t)((r >> 2) * 128 + 124 + (r & 3)) * 128 + lc; }
                    if (o) { *(f32x4*)o = v0; *(f32x4*)(o + 4) = v1; } } }
        } else if (pn < 5 || (pn >= 9 && pn < 11)) {
            bf16_t* dst = pn < 5 ? HQ : HG; const int cb = pn < 5 ? 768 : 2304;
            EPI_ROWS { const size_t row = EPI_ROW;
#pragma unroll
                for (int bj = 0; bj < 2; ++bj) { f32x4 v0 = acc[ai][bj][m][0], v1 = acc[ai][bj][m][1];
#pragma unroll
                    for (int j = 0; j < 4; ++j) { v0[j] = silu(v0[j]); v1[j] = silu(v1[j]); }
                    st_bf16x8(dst + row * 512 + (EPI_COL(bj) - cb), v0, v1); } }
        } else if (pn < 7) {
            hf_part<0, 0>(acc, u, wr, wc, fr, fq); hf_part<0, 1>(acc, u, wr, wc, fr, fq); hf_part<1, 0>(acc, u, wr, wc, fr, fq); hf_part<1, 1>(acc, u, wr, wc, fr, fq);
        } else if (pn < 9) {
            EPI_ROWS { const size_t row = EPI_ROW;
#pragma unroll
                for (int bj = 0; bj < 2; ++bj) st_bf16x8(HV + row * 512 + (EPI_COL(bj) - 1792), acc[ai][bj][m][0], acc[ai][bj][m][1]); }
        } else {
#pragma unroll
            for (int bj = 0; bj < 2; ++bj) { const int gc = EPI_COL(bj) - 2816; const f32x4 b0 = *(const f32x4*)(bgate + gc), b1 = *(const f32x4*)(bgate + gc + 4);
                EPI_ROWS { const size_t row = EPI_ROW; f32x4 v0 = acc[ai][bj][m][0] + b0, v1 = acc[ai][bj][m][1] + b1;
#pragma unroll
                    for (int j = 0; j < 4; ++j) { v0[j] = sigm(v0[j]); v1[j] = sigm(v1[j]); }
                    st_bf16x8(G + row * 2048 + gc, v0, v1); } }
        }
    }
};
struct EpiUp1 {
    static constexpr bool PERM = true, AFTER_DRAIN = false;
    const bf16_t* G; float* T;
    DI void operator()(EPI_ARGS) const {
        EPI_ROWS { const size_t row = EPI_ROW;
#pragma unroll
            for (int bj = 0; bj < 2; ++bj) { const int c = EPI_COL(bj); f32x4 g0, g1; ld_bf16x8(G + row * 2048 + c, g0, g1);
                *(f32x4*)(T + row * 1024 + c) = g0 * acc[ai][bj][m][0]; *(f32x4*)(T + row * 1024 + c + 4) = g1 * acc[ai][bj][m][1]; } asm volatile("" ::: "memory"); }
    }
};
struct EpiUp2 {
    static constexpr bool PERM = true, AFTER_DRAIN = false;
    const bf16_t* G; const float* T; bf16_t* MG;
    DI void operator()(EPI_ARGS) const {
        EPI_ROWS { const size_t row = EPI_ROW;
#pragma unroll
            for (int bj = 0; bj < 2; ++bj) { const int c = EPI_COL(bj); f32x4 g0, g1; ld_bf16x8(G + row * 2048 + 1024 + c, g0, g1);
                const f32x4 t0 = *(const f32x4*)(T + row * 1024 + c), t1 = *(const f32x4*)(T + row * 1024 + c + 4);
                st_bf16x8(MG + row * 1024 + c, t0 + g0 * acc[ai][bj][m][0], t1 + g1 * acc[ai][bj][m][1]); } asm volatile("" ::: "memory"); }
    }
};
struct EpiRes {
    static constexpr bool PERM = true, AFTER_DRAIN = false;
    const float* X; float* Y;
    DI void operator()(EPI_ARGS) const {
        EPI_ROWS { const size_t row = EPI_ROW;
#pragma unroll
            for (int bj = 0; bj < 2; ++bj) { const int c = EPI_COL(bj);
                const f32x4 x0 = *(const f32x4*)(X + row * 1024 + c), x1 = *(const f32x4*)(X + row * 1024 + c + 4);
                *(f32x4*)(Y + row * 1024 + c) = x0 * ALPHA + acc[ai][bj][m][0]; *(f32x4*)(Y + row * 1024 + c + 4) = x1 * ALPHA + acc[ai][bj][m][1]; } asm volatile("" ::: "memory"); }
    }
};
struct EpiRelu2 {
    static constexpr bool PERM = true, AFTER_DRAIN = false;
    bf16_t* HB;
    DI void operator()(EPI_ARGS) const {
        EPI_ROWS { const size_t row = EPI_ROW;
#pragma unroll
            for (int bj = 0; bj < 2; ++bj) { f32x4 v0 = acc[ai][bj][m][0], v1 = acc[ai][bj][m][1];
#pragma unroll
                for (int j = 0; j < 4; ++j) { const float a = fmaxf(v0[j], 0.f), b = fmaxf(v1[j], 0.f); v0[j] = a * a; v1[j] = b * b; }
                st_bf16x8(HB + row * 4096 + EPI_COL(bj), v0, v1); } asm volatile("" ::: "memory"); }
    }
};


template <int K, class Epi>
DI void sample_gemm_tiles(LAS unsigned char* lds, const bf16_t* A, int lda, const bf16_t* Bt, int ldb, int N, const Epi& E, int bid, int G, int tid) {
    const int wave = __builtin_amdgcn_readfirstlane(tid >> 6), lane = tid & 63, fr = lane & 15, fq = lane >> 4;
    constexpr int KSL = K / 8;
    const int ntiles = 16 * (N / 64), k0 = wave * KSL;
    LAS float* red = (LAS float*)lds;
    for (int t = bid; t < ntiles; t += G) {
        const int rb = t & 15, cb = t >> 4;
        const bf16_t* ap = A + (size_t)(rb * 32 + fr) * lda + k0 + 8 * fq;
        const bf16_t* bp = Bt + (size_t)(cb * 64 + fr) * ldb + k0 + 8 * fq;
        f32x4 acc[2][4];
#pragma unroll
        for (int m = 0; m < 2; ++m)
#pragma unroll
            for (int n = 0; n < 4; ++n) acc[m][n] = (f32x4){0.f, 0.f, 0.f, 0.f};
#pragma unroll 4
        for (int ks = 0; ks < KSL; ks += 32) {
            bf16x8 a[2], b[4];
#pragma unroll
            for (int m = 0; m < 2; ++m) a[m] = *(const bf16x8*)(ap + (size_t)m * 16 * lda + ks);
#pragma unroll
            for (int n = 0; n < 4; ++n) b[n] = *(const bf16x8*)(bp + (size_t)n * 16 * ldb + ks);
#pragma unroll
            for (int m = 0; m < 2; ++m)
#pragma unroll
                for (int n = 0; n < 4; ++n) acc[m][n] = MFMA16(b[n], a[m], acc[m][n]);
        }
        __syncthreads();
#pragma unroll
        for (int m = 0; m < 2; ++m)
#pragma unroll
            for (int n = 0; n < 4; ++n) *(LAS f32x4*)(red + (wave * 32 + 16 * m + fr) * 68 + 16 * n + 4 * fq) = acc[m][n];
        __syncthreads();
        const int row = tid >> 4, c4 = (tid & 15) * 4;
        f32x4 lo = {0.f, 0.f, 0.f, 0.f}, hi = {0.f, 0.f, 0.f, 0.f};
#pragma unroll
        for (int w = 0; w < 4; ++w) { lo += *(const LAS f32x4*)(red + (w * 32 + row) * 68 + c4); hi += *(const LAS f32x4*)(red + ((w + 4) * 32 + row) * 68 + c4); }
        E((size_t)(MP + rb * 32 + row), cb * 64 + c4, lo, hi);
    }
}
DI f32x4 ld_bf16x4(const bf16_t* p) { const u32x2 w = *(const u32x2*)p; return (f32x4){bflo(w.x), bfhi(w.x), bflo(w.y), bfhi(w.y)}; }
DI void st_bf16x4(bf16_t* p, f32x4 v) { u32x2 w; w.x = pk2(v[0], v[1]); w.y = pk2(v[2], v[3]); *(u32x2*)p = w; }
struct SEpiUp { const bf16_t* G; bf16_t* MG;
    DI void operator()(size_t row, int col, f32x4 lo, f32x4 hi) const { st_bf16x4(MG + row * 1024 + col, ld_bf16x4(G + row * 2048 + col) * lo + ld_bf16x4(G + row * 2048 + 1024 + col) * hi); } };
struct SEpiRes { const float* X; float* Y;
    DI void operator()(size_t row, int col, f32x4 lo, f32x4 hi) const { *(f32x4*)(Y + row * 1024 + col) = *(const f32x4*)(X + row * 1024 + col) * ALPHA + (lo + hi); } };
struct SEpiRelu2 { bf16_t* HB;
    DI void operator()(size_t row, int col, f32x4 lo, f32x4 hi) const { f32x4 v = lo + hi;
#pragma unroll
        for (int j = 0; j < 4; ++j) { const float a = fmaxf(v[j], 0.f); v[j] = a * a; }
        st_bf16x4(HB + row * 4096 + col, v); } };

constexpr int PARAM_LDS_OFF = 131072 + 1024;
struct Ctx {
    LAS unsigned char* lds0;
    DI unsigned long long ptr(int i) const { unsigned off = PARAM_LDS_OFF + 8 * i; asm volatile("" : "+s"(off));
        volatile LAS const unsigned* q = (volatile LAS const unsigned*)(lds0 + off);
        const unsigned lo = __builtin_amdgcn_readfirstlane(q[0]), hi = __builtin_amdgcn_readfirstlane(q[1]); return ((unsigned long long)hi << 32) | lo; }
    DI const float* in(int i) const { return (const float*)ptr(i); }
    DI float* out() const { return (float*)ptr(19); }
    DI unsigned char* ws() const { return (unsigned char*)ptr(20); }
#define CTXP(T, name, off) DI T* name() const { return (T*)(ws() + (off)); }
    CTXP(float, X, WS_X) CTXP(float, Y, WS_Y) CTXP(float, LOGF, WS_LOGF) CTXP(float, DST, WS_DST) CTXP(float, DEC, WS_DEC) CTXP(float, LBT, WS_LBT)
    CTXP(bf16_t, XB, WS_XB) CTXP(bf16_t, G, WS_G) CTXP(bf16_t, AH, WS_AH) CTXP(bf16_t, HB, WS_HB) CTXP(bf16_t, MG, WS_MG) CTXP(bf16_t, HQ, WS_HQ) CTXP(bf16_t, HK, WS_HK)
    CTXP(bf16_t, HV, WS_HV) CTXP(bf16_t, HG, WS_HG) CTXP(bf16_t, SB, WS_SB) CTXP(bf16_t, AQ, WS_AQ) CTXP(bf16_t, AK, WS_AK) CTXP(bf16_t, AV, WS_AV)
    CTXP(bf16_t, WIN, WS_WIN) CTXP(bf16_t, WUP, WS_WUP) CTXP(bf16_t, WOUT, WS_WOUT) CTXP(bf16_t, WFF1, WS_WFF1) CTXP(bf16_t, WFF2, WS_WFF2)
#undef CTXP
};
enum { I_XP = 0, I_XS, I_CK, I_CV, I_ST, I_WIN, I_BG, I_SINK, I_LB, I_NW, I_WUA, I_WUH, I_WOUT, I_L1G, I_L1B, I_WF1, I_WF2, I_L2G, I_L2B };

DI void transpose_item(const float* W, int N, bf16_t* WT, int ldt, int koff, LAS float* scr, int item, int lane) {
    const int nblk = N / 32, kb = item / nblk, nb = item % nblk, k0 = 64 * kb, n0 = 32 * nb;
#pragma unroll 8
    for (int i = 0; i < 32; ++i) { const int kk = 2 * i + (lane >> 5); scr[kk * 33 + (lane & 31)] = W[(size_t)(k0 + kk) * N + n0 + (lane & 31)]; }
    LDS_WAIT();
    const int c = lane & 7;
#pragma unroll
    for (int j = 0; j < 4; ++j) { const int n = (lane >> 3) + 8 * j; const LAS float* s = scr + (8 * c) * 33 + n;
        u32x4 o; o.x = pk2(s[0 * 33], s[1 * 33]); o.y = pk2(s[2 * 33], s[3 * 33]); o.z = pk2(s[4 * 33], s[5 * 33]); o.w = pk2(s[6 * 33], s[7 * 33]);
        *(u32x4*)(WT + (size_t)(n0 + n) * ldt + koff + k0 + 8 * c) = o; }
    LDS_WAIT();
}
DI void convert_layer(const Ctx& c, int l, LAS unsigned char* lds, int gw, int ngw, int wave, int lane) {
    LAS float* scr = (LAS float*)(lds + wave * 16384);
    constexpr int I_IN = (DM / 64) * (NIN / 32), I_UP = (512 / 64) * (DM / 32), I_OUT = (DM / 64) * (DM / 32), I_F1 = (DM / 64) * (FF / 32), I_F2 = (FF / 64) * (DM / 32);
    constexpr int NITEMS = I_IN + 2 * I_UP + I_OUT + I_F1 + I_F2;
    for (int it = gw; it < NITEMS; it += ngw) {
        int r = it;
        if (r < I_IN) { transpose_item(c.in(I_WIN) + (size_t)l * DM * NIN, NIN, c.WIN(), DM, 0, scr, r, lane); continue; } r -= I_IN;
        if (r < I_UP) { transpose_item(c.in(I_WUA) + (size_t)l * 512 * DM, DM, c.WUP(), DM, 0, scr, r, lane); continue; } r -= I_UP;
        if (r < I_UP) { transpose_item(c.in(I_WUH) + (size_t)l * 512 * DM, DM, c.WUP(), DM, 512, scr, r, lane); continue; } r -= I_UP;
        if (r < I_OUT) { transpose_item(c.in(I_WOUT) + (size_t)l * DM * DM, DM, c.WOUT(), DM, 0, scr, r, lane); continue; } r -= I_OUT;
        if (r < I_F1) { transpose_item(c.in(I_WF1) + (size_t)l * DM * FF, FF, c.WFF1(), DM, 0, scr, r, lane); continue; } r -= I_F1;
        transpose_item(c.in(I_WF2) + (size_t)l * FF * DM, DM, c.WFF2(), FF, 0, scr, r, lane);
    }
}
DI void ln_row(const float* src, const float* g, const float* b, float* xrow, bf16_t* xbrow, float* extra, int lane, bool do_ln) {
    const f32x4* xr = (const f32x4*)src + lane;
    f32x4 v[4]; float s = 0.f;
#pragma unroll
    for (int j = 0; j < 4; ++j) { v[j] = xr[64 * j]; s += (v[j][0] + v[j][1]) + (v[j][2] + v[j][3]); }
    if (do_ln) {
        const float mean = wave_sum(s) * (1.f / DM); float s2 = 0.f;
#pragma unroll
        for (int j = 0; j < 4; ++j) { v[j] = v[j] - mean; s2 += (v[j][0] * v[j][0] + v[j][1] * v[j][1]) + (v[j][2] * v[j][2] + v[j][3] * v[j][3]); }
        const float rstd = 1.f / sqrtf(wave_sum(s2) * (1.f / DM) + LN_EPS);
#pragma unroll
        for (int j = 0; j < 4; ++j) { const f32x4 gg = ((const f32x4*)g)[lane + 64 * j], bb = ((const f32x4*)b)[lane + 64 * j]; v[j] = v[j] * rstd * gg + bb; }
    }
#pragma unroll
    for (int j = 0; j < 4; ++j) {
        ((f32x4*)xrow)[lane + 64 * j] = v[j];
        if (extra) ((f32x4*)extra)[lane + 64 * j] = v[j];
        u32x2 w; w.x = pk2(v[j][0], v[j][1]); w.y = pk2(v[j][2], v[j][3]); ((u32x2*)xbrow)[lane + 64 * j] = w;
    }
}

DI void attn_prompt_unit(const Ctx& c, const float* sink_l, int u, LAS unsigned char* lds, int tid) {
    const int wave = tid >> 6, lane = tid & 63, fr = lane & 15, fq = lane >> 4;
    const int b = u >> 6, blk = (u >> 1) & 31, kvh = u & 1;
    LAS bf16_t* Ks = (LAS bf16_t*)lds;
    LAS bf16_t* VT = (LAS bf16_t*)(lds + 36864);
    const int rowq0 = b * 4096 + blk * 128;
    __syncthreads();
#pragma unroll
    for (int i = 0; i < 4; ++i) { const int ch = tid + 512 * i, key = ch >> 3, dp = ch & 7;
        int t = (blk - 1) * 128 + key; if (t < 0) t = key;
        const size_t grow = (size_t)(b * 4096 + t);
        const u32x4 kv = *(const u32x4*)(c.AK() + grow * 128 + kvh * 64 + dp * 8);
        const u32x4 vv = *(const u32x4*)(c.AV() + grow * 128 + kvh * 64 + dp * 8);
        *(LAS u32x4*)(Ks + key * 72 + dp * 8) = kv;
        LAS bf16_t* vt = VT + (dp * 8) * 264 + key;
        vt[0 * 264] = (bf16_t)(vv.x & 0xffffu); vt[1 * 264] = (bf16_t)(vv.x >> 16); vt[2 * 264] = (bf16_t)(vv.y & 0xffffu); vt[3 * 264] = (bf16_t)(vv.y >> 16);
        vt[4 * 264] = (bf16_t)(vv.z & 0xffffu); vt[5 * 264] = (bf16_t)(vv.z >> 16); vt[6 * 264] = (bf16_t)(vv.w & 0xffffu); vt[7 * 264] = (bf16_t)(vv.w >> 16); }
    __syncthreads();
    const int lo = wave & ~1, qi = 16 * wave + fr;
#pragma unroll 1
    for (int g = 0; g < 4; ++g) {
        const float sink = sink_l[kvh * 4 + g];
        const bf16_t* qp = c.AQ() + (size_t)(rowq0 + qi) * 512 + (kvh * 4 + g) * 64 + 8 * fq;
        const bf16x8 q0 = *(const bf16x8*)qp, q1 = *(const bf16x8*)(qp + 32);
        f32x4 s[10]; float mx = sink;
#pragma unroll
        for (int t = 0; t < 10; ++t) { const LAS bf16_t* kp = Ks + (16 * (lo + t) + fr) * 72 + 8 * fq;
            const bf16x8 k0 = *(const LAS bf16x8*)kp, k1 = *(const LAS bf16x8*)(kp + 32);
            f32x4 a = {0.f, 0.f, 0.f, 0.f}; a = MFMA16(k0, q0, a); a = MFMA16(k1, q1, a);
#pragma unroll
            for (int i = 0; i < 4; ++i) { const int kj = 16 * (lo + t) + 4 * fq + i; const bool valid = (kj >= qi) && (kj <= qi + 128) && (blk > 0 || kj >= 128);
                a[i] = valid ? a[i] : -1e30f; mx = fmaxf(mx, a[i]); }
            s[t] = a; }
        mx = fmaxf(mx, __shfl_xor(mx, 16)); mx = fmaxf(mx, __shfl_xor(mx, 32));
        float sum = 0.f;
#pragma unroll
        for (int t = 0; t < 10; ++t)
#pragma unroll
            for (int i = 0; i < 4; ++i) { const float pe = __expf(s[t][i] - mx); s[t][i] = pe; sum += pe; }
        sum += __shfl_xor(sum, 16); sum += __shfl_xor(sum, 32);
        sum += __expf(sink - mx);
        const float inv = 1.f / sum;
        f32x4 o[4];
#pragma unroll
        for (int dt = 0; dt < 4; ++dt) o[dt] = (f32x4){0.f, 0.f, 0.f, 0.f};
#pragma unroll
        for (int j = 0; j < 5; ++j) { u32x4 pw; pw.x = pk2(s[2 * j][0] * inv, s[2 * j][1] * inv); pw.y = pk2(s[2 * j][2] * inv, s[2 * j][3] * inv);
            pw.z = pk2(s[2 * j + 1][0] * inv, s[2 * j + 1][1] * inv); pw.w = pk2(s[2 * j + 1][2] * inv, s[2 * j + 1][3] * inv);
            const bf16x8 pf = __builtin_bit_cast(bf16x8, pw);
#pragma unroll
            for (int dt = 0; dt < 4; ++dt) { const LAS bf16_t* vp = VT + (16 * dt + fr) * 264 + 16 * lo + 32 * j + 4 * fq;
                const u32x2 va = *(const LAS u32x2*)vp, vb = *(const LAS u32x2*)(vp + 16); u32x4 vw; vw.x = va.x; vw.y = va.y; vw.z = vb.x; vw.w = vb.y;
                o[dt] = MFMA16(__builtin_bit_cast(bf16x8, vw), pf, o[dt]); } }
#pragma unroll
        for (int dt = 0; dt < 4; ++dt) { bf16_t* op = c.AH() + (size_t)(rowq0 + qi) * 1024 + (kvh * 4 + g) * 64 + 16 * dt + 4 * fq;
            u32x2 w; w.x = pk2(o[dt][0], o[dt][1]); w.y = pk2(o[dt][2], o[dt][3]); *(u32x2*)op = w; }
    }
}
DI void attn_sample_unit(const Ctx& c, const float* sink_l, int l, int u, LAS unsigned char* lds, int tid) {
    const int wave = tid >> 6, lane = tid & 63;
    const int bs = u >> 1, kvh = u & 1;
    LAS float* Ksm = (LAS float*)lds;
    LAS float* Vsm = Ksm + 132 * 65;
    LAS float* Qsm = Vsm + 132 * 64;
    LAS float* Psm = Qsm + 16 * 64;
    const float* ck = c.in(I_CK) + ((size_t)(l * 128 + bs) * 128) * 128 + kvh * 64;
    const float* cv = c.in(I_CV) + ((size_t)(l * 128 + bs) * 128) * 128 + kvh * 64;
    float* ok = c.out() + O_SK + ((size_t)(l * 128 + bs) * 128) * 128 + kvh * 64;
    float* ov = c.out() + O_SV + ((size_t)(l * 128 + bs) * 128) * 128 + kvh * 64;
    __syncthreads();
#pragma unroll
    for (int i = 0; i < 4; ++i) { const int idx = tid + 512 * i, j = idx >> 4, d4 = (idx & 15) * 4;
        const f32x4 kk = *(const f32x4*)(ck + (size_t)j * 128 + d4), vv = *(const f32x4*)(cv + (size_t)j * 128 + d4);
        Ksm[j * 65 + d4 + 0] = kk[0]; Ksm[j * 65 + d4 + 1] = kk[1]; Ksm[j * 65 + d4 + 2] = kk[2]; Ksm[j * 65 + d4 + 3] = kk[3];
        Vsm[j * 64 + d4 + 0] = vv[0]; Vsm[j * 64 + d4 + 1] = vv[1]; Vsm[j * 64 + d4 + 2] = vv[2]; Vsm[j * 64 + d4 + 3] = vv[3];
        if (j >= 4) { *(f32x4*)(ok + (size_t)(j - 4) * 128 + d4) = kk; *(f32x4*)(ov + (size_t)(j - 4) * 128 + d4) = vv; } }
    if (tid < 256) { const int t = tid >> 6, d = tid & 63; const size_t row = (size_t)(MP + bs * 4 + t);
        Ksm[(128 + t) * 65 + d] = bf2f(c.AK()[row * 128 + kvh * 64 + d]); Vsm[(128 + t) * 64 + d] = bf2f(c.AV()[row * 128 + kvh * 64 + d]); }
#pragma unroll
    for (int i = 0; i < 2; ++i) { const int idx = tid + 512 * i, r = idx >> 6, d = idx & 63, t = r >> 2, g = r & 3;
        Qsm[r * 64 + d] = bf2f(c.AQ()[(size_t)(MP + bs * 4 + t) * 512 + (kvh * 4 + g) * 64 + d]); }
    __syncthreads();
    for (int e = tid; e < 16 * 132; e += 512) { const int r = e / 132, j = e - r * 132, t = r >> 2;
        float a = 0.f;
#pragma unroll 8
        for (int d = 0; d < 64; ++d) a += Qsm[r * 64 + d] * Ksm[j * 65 + d];
        const bool valid = (j >= t) && (j <= 128 + t);
        Psm[r * 136 + j] = valid ? a : -1e30f; }
    __syncthreads();
#pragma unroll
    for (int rr = 0; rr < 2; ++rr) { const int r = 2 * wave + rr, g = r & 3; const float sink = sink_l[kvh * 4 + g];
        float v[3]; float mx = sink;
#pragma unroll
        for (int k = 0; k < 3; ++k) { const int j = lane + 64 * k; v[k] = (j < 132) ? Psm[r * 136 + j] : -1e30f; mx = fmaxf(mx, v[k]); }
#pragma unroll
        for (int o = 1; o < 64; o <<= 1) mx = fmaxf(mx, __shfl_xor(mx, o));
        float sum = 0.f;
#pragma unroll
        for (int k = 0; k < 3; ++k) { v[k] = __expf(v[k] - mx); sum += v[k]; }
        sum = wave_sum(sum) + __expf(sink - mx);
        const float inv = 1.f / sum;
#pragma unroll
        for (int k = 0; k < 3; ++k) { const int j = lane + 64 * k; if (j < 132) Psm[r * 136 + j] = v[k] * inv; } }
    __syncthreads();
#pragma unroll
    for (int i = 0; i < 2; ++i) { const int o = tid + 512 * i, r = o >> 6, d = o & 63;
        float a = 0.f;
        for (int j = 0; j < 132; ++j) a += Psm[r * 136 + j] * Vsm[j * 64 + d];
        c.AH()[(size_t)(MP + bs * 4 + (r >> 2)) * 1024 + (kvh * 4 + (r & 3)) * 64 + d] = f2bf(a); }
}
DI void hg_cumsum(const float* LOGF, int r0, int h, int d, int seg, LAS float* segtot, float (&bcs)[16], float& bend, float& bmid) {
    const float* lp = LOGF + (size_t)(r0 + 16 * seg) * 512 + h * 128 + d;
#pragma unroll
    for (int i = 0; i < 16; ++i) bcs[i] = lp[(size_t)i * 512];
    float run = 0.f;
#pragma unroll
    for (int i = 0; i < 16; ++i) { run += bcs[i]; bcs[i] = run; }
    segtot[seg * 128 + d] = run;
    __syncthreads();
    const float s0 = segtot[d], s1 = segtot[128 + d], s2 = segtot[256 + d], s3 = segtot[384 + d];
    const float off = seg == 0 ? 0.f : seg == 1 ? s0 : seg == 2 ? (s0 + s1) : (s0 + s1 + s2);
#pragma unroll
    for (int i = 0; i < 16; ++i) bcs[i] += off;
    bend = (s0 + s1) + (s2 + s3); bmid = s0 + s1;
}
DI void hg_pass1_unit(const Ctx& c, int u, LAS unsigned char* lds, int tid) {
    const int wave = tid >> 6, lane = tid & 63, fr = lane & 15, fq = lane >> 4;
    const int bh = u >> 6, ci = u & 63, bb = bh >> 2, h = bh & 3, r0 = bb * 4096 + 64 * ci;
    LAS bf16_t* KT = (LAS bf16_t*)lds;
    LAS bf16_t* VT = KT + 128 * 72;
    LAS float* segtot = (LAS float*)(lds + 2 * 128 * 72 * 2);
    const int d = tid & 127, seg = tid >> 7;
    __syncthreads();
    float bcs[16], bend, bmid; hg_cumsum(c.LOGF(), r0, h, d, seg, segtot, bcs, bend, bmid);
    const bf16_t* kp = c.HK() + (size_t)(r0 + 16 * seg) * 512 + h * 128 + d;
    const bf16_t* vp = c.HV() + (size_t)(r0 + 16 * seg) * 512 + h * 128 + d;
    unsigned kw[8], vw[8];
#pragma unroll
    for (int i = 0; i < 8; ++i) { const float k0 = bf2f(kp[(size_t)(2 * i) * 512]) * __expf(bend - bcs[2 * i]), k1 = bf2f(kp[(size_t)(2 * i + 1) * 512]) * __expf(bend - bcs[2 * i + 1]);
        kw[i] = pk2(k0, k1); vw[i] = (unsigned)vp[(size_t)(2 * i) * 512] | ((unsigned)vp[(size_t)(2 * i + 1) * 512] << 16); }
    *(LAS u32x4*)(KT + d * 72 + 16 * seg) = (u32x4){kw[0], kw[1], kw[2], kw[3]}; *(LAS u32x4*)(KT + d * 72 + 16 * seg + 8) = (u32x4){kw[4], kw[5], kw[6], kw[7]};
    *(LAS u32x4*)(VT + d * 72 + 16 * seg) = (u32x4){vw[0], vw[1], vw[2], vw[3]}; *(LAS u32x4*)(VT + d * 72 + 16 * seg + 8) = (u32x4){vw[4], vw[5], vw[6], vw[7]};
    if (seg == 0) c.DEC()[(size_t)u * 128 + d] = __expf(bend);
    __syncthreads();
    const LAS bf16_t* ap = VT + (16 * wave + fr) * 72 + 8 * fq;
    const bf16x8 a0 = *(const LAS bf16x8*)ap, a1 = *(const LAS bf16x8*)(ap + 32);
    float* dst = c.DST() + (size_t)u * 16384;
#pragma unroll
    for (int nt = 0; nt < 8; ++nt) { const LAS bf16_t* bp = KT + (16 * nt + fr) * 72 + 8 * fq;
        const bf16x8 b0 = *(const LAS bf16x8*)bp, b1 = *(const LAS bf16x8*)(bp + 32);
        f32x4 a = {0.f, 0.f, 0.f, 0.f}; a = MFMA16(a0, b0, a); a = MFMA16(a1, b1, a);
#pragma unroll
        for (int i = 0; i < 4; ++i) dst[(16 * wave + 4 * fq + i) * 128 + 16 * nt + fr] = a[i]; }
}
DI void hg_scan(const Ctx& c, float* ps_l, int gtid, int gthreads) {
    for (int it = gtid; it < 16 * 8192; it += gthreads) {
        const int bh = it >> 13, ed2 = it & 8191, e = ed2 >> 6, d = (ed2 & 63) * 2;
        f32x2 S = {0.f, 0.f};
        const float* dp = c.DST() + (size_t)(bh * 64) * 16384 + e * 128 + d;
        const float* qp = c.DEC() + (size_t)(bh * 64) * 128 + d;
        bf16_t* sp = c.SB() + (size_t)(bh * 64) * 16384 + e * 128 + d;
#pragma unroll 8
        for (int cc = 0; cc < 64; ++cc) { const f32x2 ds = *(const f32x2*)(dp + (size_t)cc * 16384), dc = *(const f32x2*)(qp + (size_t)cc * 128);
            *(unsigned*)(sp + (size_t)cc * 16384) = pk2(S[0], S[1]); S = dc * S + ds; }
        ps_l[(size_t)bh * 16384 + d * 128 + e] = S[0]; ps_l[(size_t)bh * 16384 + (d + 1) * 128 + e] = S[1];
    }
}
DI void hg_pass3_unit(const Ctx& c, const float* normw_l, int u, LAS unsigned char* lds, int tid) {
    const int wave = tid >> 6, lane = tid & 63, fr = lane & 15, fq = lane >> 4;
    const int bh = u >> 6, ci = u & 63, bb = bh >> 2, h = bh & 3, r0 = bb * 4096 + 64 * ci;
    LAS bf16_t* QS = (LAS bf16_t*)lds;
    LAS bf16_t* QM = QS + 64 * 136;
    LAS bf16_t* KM = QM + 64 * 136;
    LAS bf16_t* VT = KM + 64 * 136;
    LAS bf16_t* ATT = VT + 128 * 72;
    LAS float* segtot = (LAS float*)(ATT + 64 * 72);
    LAS float* ssq = segtot + 512;
    const int d = tid & 127, seg = tid >> 7;
    __syncthreads();
    float bcs[16], bend, bmid; hg_cumsum(c.LOGF(), r0, h, d, seg, segtot, bcs, bend, bmid);
    {
        const bf16_t* qp = c.HQ() + (size_t)(r0 + 16 * seg) * 512 + h * 128 + d;
        const bf16_t* kp = c.HK() + (size_t)(r0 + 16 * seg) * 512 + h * 128 + d;
        const bf16_t* vp = c.HV() + (size_t)(r0 + 16 * seg) * 512 + h * 128 + d;
        unsigned vw[8];
#pragma unroll
        for (int i = 0; i < 16; ++i) { const int t = 16 * seg + i; const float q = bf2f(qp[(size_t)i * 512]), k = bf2f(kp[(size_t)i * 512]);
            QS[t * 136 + d] = f2bf(q * __expf(bcs[i])); QM[t * 136 + d] = f2bf(q * __expf(bcs[i] - bmid)); KM[t * 136 + d] = f2bf(k * __expf(bmid - bcs[i])); }
#pragma unroll
        for (int i = 0; i < 8; ++i) vw[i] = (unsigned)vp[(size_t)(2 * i) * 512] | ((unsigned)vp[(size_t)(2 * i + 1) * 512] << 16);
        *(LAS u32x4*)(VT + d * 72 + 16 * seg) = (u32x4){vw[0], vw[1], vw[2], vw[3]}; *(LAS u32x4*)(VT + d * 72 + 16 * seg + 8) = (u32x4){vw[4], vw[5], vw[6], vw[7]};
    }
    __syncthreads();
    {
        const int mt = wave >> 1;
        bf16x8 af[4];
#pragma unroll
        for (int kk = 0; kk < 4; ++kk) af[kk] = *(const LAS bf16x8*)(QM + (16 * mt + fr) * 136 + 32 * kk + 8 * fq);
#pragma unroll
        for (int n2 = 0; n2 < 2; ++n2) { const int nt = (wave & 1) * 2 + n2; f32x4 a = {0.f, 0.f, 0.f, 0.f};
#pragma unroll
            for (int kk = 0; kk < 4; ++kk) a = MFMA16(af[kk], *(const LAS bf16x8*)(KM + (16 * nt + fr) * 136 + 32 * kk + 8 * fq), a);
#pragma unroll
            for (int i = 0; i < 4; ++i) { const int t = 16 * mt + 4 * fq + i, s = 16 * nt + fr; ATT[t * 72 + s] = f2bf(s <= t ? a[i] : 0.f); } }
    }
    __syncthreads();
    const int tt = wave & 3, eh = wave >> 2;
    bf16x8 qs[4], at[2];
#pragma unroll
    for (int kk = 0; kk < 4; ++kk) qs[kk] = *(const LAS bf16x8*)(QS + (16 * tt + fr) * 136 + 32 * kk + 8 * fq);
#pragma unroll
    for (int kk = 0; kk < 2; ++kk) at[kk] = *(const LAS bf16x8*)(ATT + (16 * tt + fr) * 72 + 32 * kk + 8 * fq);
    f32x4 o[4]; float ss = 0.f;
    const bf16_t* sb = c.SB() + (size_t)u * 16384;
#pragma unroll
    for (int j = 0; j < 4; ++j) { const int et = 4 * eh + j; f32x4 a = {0.f, 0.f, 0.f, 0.f};
#pragma unroll
        for (int kk = 0; kk < 4; ++kk) a = MFMA16(*(const bf16x8*)(sb + (16 * et + fr) * 128 + 32 * kk + 8 * fq), qs[kk], a);
#pragma unroll
        for (int kk = 0; kk < 2; ++kk) a = MFMA16(*(const LAS bf16x8*)(VT + (16 * et + fr) * 72 + 32 * kk + 8 * fq), at[kk], a);
        o[j] = a; ss += (a[0] * a[0] + a[1] * a[1]) + (a[2] * a[2] + a[3] * a[3]); }
    ss += __shfl_xor(ss, 16); ss += __shfl_xor(ss, 32);
    if (fq == 0) ssq[eh * 64 + 16 * tt + fr] = ss;
    __syncthreads();
    const float rinv = rsqrtf((ssq[16 * tt + fr] + ssq[64 + 16 * tt + fr]) * (1.f / 128.f) + RMS_EPS);
    const size_t row = (size_t)(r0 + 16 * tt + fr);
#pragma unroll
    for (int j = 0; j < 4; ++j) { const int e0 = 16 * (4 * eh + j) + 4 * fq;
        const u32x2 hw = *(const u32x2*)(c.HG() + row * 512 + h * 128 + e0); const f32x4 nw = *(const f32x4*)(normw_l + e0);
        const float r0_ = o[j][0] * rinv * nw[0] * bflo(hw.x), r1_ = o[j][1] * rinv * nw[1] * bfhi(hw.x), r2_ = o[j][2] * rinv * nw[2] * bflo(hw.y), r3_ = o[j][3] * rinv * nw[3] * bfhi(hw.y);
        u32x2 w; w.x = pk2(r0_, r1_); w.y = pk2(r2_, r3_); *(u32x2*)(c.AH() + row * 1024 + 512 + h * 128 + e0) = w; }
}
DI void hg_sample_unit(const Ctx& c, const float* normw_l, int l, int u, LAS unsigned char* lds, int tid) {
    const int wave = tid >> 6, lane = tid & 63;
    const int bs = u >> 2, h = u & 3;
    LAS float* red = (LAS float*)lds;
    LAS float* ssq = red + 4 * 16 * 128;
    const int dg = tid >> 5, e4 = (tid & 31) * 4;
    const float* sp = c.in(I_ST) + ((size_t)((l * 128 + bs) * 4 + h)) * 16384;
    float* so = c.out() + O_SS + ((size_t)((l * 128 + bs) * 4 + h)) * 16384;
    __syncthreads();
    f32x4 S[8];
#pragma unroll
    for (int dd = 0; dd < 8; ++dd) S[dd] = *(const f32x4*)(sp + (dg * 8 + dd) * 128 + e4);
#pragma unroll
    for (int t = 0; t < 4; ++t) { const size_t row = (size_t)(MP + bs * 4 + t);
        const u32x2 vw = *(const u32x2*)(c.HV() + row * 512 + h * 128 + e4); const f32x4 v = {bflo(vw.x), bfhi(vw.x), bflo(vw.y), bfhi(vw.y)};
        f32x4 po = {0.f, 0.f, 0.f, 0.f};
#pragma unroll
        for (int dd = 0; dd < 8; ++dd) { const size_t ix = row * 512 + h * 128 + dg * 8 + dd;
            const float f = __expf(c.LOGF()[ix]), k = bf2f(c.HK()[ix]), q = bf2f(c.HQ()[ix]);
            S[dd] = S[dd] * f + v * k; po = po + S[dd] * q; }
        *(LAS f32x4*)(red + (t * 16 + dg) * 128 + e4) = po; }
#pragma unroll
    for (int dd = 0; dd < 8; ++dd) *(f32x4*)(so + (dg * 8 + dd) * 128 + e4) = S[dd];
    __syncthreads();
    const int t = tid >> 7, e = tid & 127;
    float o = 0.f;
#pragma unroll
    for (int g = 0; g < 16; ++g) o += red[(t * 16 + g) * 128 + e];
    const float ss = wave_sum(o * o);
    if (lane == 0) ssq[wave] = ss;
    __syncthreads();
    const float rinv = rsqrtf((ssq[wave & ~1] + ssq[(wave & ~1) + 1]) * (1.f / 128.f) + RMS_EPS);
    const size_t row = (size_t)(MP + bs * 4 + t);
    c.AH()[row * 1024 + 512 + h * 128 + e] = f2bf(o * rinv * normw_l[e] * bf2f(c.HG()[row * 512 + h * 128 + e]));
}

#define OPQ_S(x) ({ int s_ = (x); asm volatile("" : "+s"(s_)); s_; })
#define OPAQUE_TID() ({ int t_ = threadIdx.x; asm volatile("" : "+v"(t_)); t_; })
#ifndef PHM
#define PHM 0xFFFFF
#endif
__global__ void __launch_bounds__(NTHREADS, 2) hybrid_fwd(Params p) {
    extern __shared__ __attribute__((aligned(16))) unsigned char lds_raw[];
    LAS unsigned char* lds = (LAS unsigned char*)lds_raw;
    cg::grid_group grid = cg::this_grid();
    const int tid = threadIdx.x, lane = tid & 63, wave = __builtin_amdgcn_readfirstlane(tid >> 6);
    const int G = gridDim.x, bid = blockIdx.x;
    const int gw = bid * NWAVES + wave, ngw = G * NWAVES;
    Ctx c; c.lds0 = lds;
    if (tid == 0) { LAS unsigned long long* w = (LAS unsigned long long*)(lds + PARAM_LDS_OFF);
        w[0] = (unsigned long long)p.x_prompt; w[1] = (unsigned long long)p.x_sample; w[2] = (unsigned long long)p.cache_k; w[3] = (unsigned long long)p.cache_v; w[4] = (unsigned long long)p.state;
        w[5] = (unsigned long long)p.w_in; w[6] = (unsigned long long)p.b_gate; w[7] = (unsigned long long)p.sink; w[8] = (unsigned long long)p.lb_logits; w[9] = (unsigned long long)p.norm_w;
        w[10] = (unsigned long long)p.w_upa; w[11] = (unsigned long long)p.w_uph; w[12] = (unsigned long long)p.w_out; w[13] = (unsigned long long)p.ln1g; w[14] = (unsigned long long)p.ln1b;
        w[15] = (unsigned long long)p.w_ff1; w[16] = (unsigned long long)p.w_ff2; w[17] = (unsigned long long)p.ln2g; w[18] = (unsigned long long)p.ln2b; w[19] = (unsigned long long)p.out; w[20] = (unsigned long long)p.ws; }
    __syncthreads();

    if (PHM & 1) convert_layer(c, 0, lds, gw, ngw, wave, lane);
    if (PHM & 1) for (int m = gw; m < MT; m += ngw) {
        const float* src = m < MP ? c.in(I_XP) + (size_t)m * DM : c.in(I_XS) + (size_t)(m - MP) * DM;
        ln_row(src, nullptr, nullptr, c.X() + (size_t)m * DM, c.XB() + (size_t)m * DM, nullptr, lane, false);
    }
    if (bid == 0) {
        const int d = tid;
        float z[4], mx = -3.0e38f;
#pragma unroll
        for (int l = 0; l < 4; ++l) { z[l] = c.in(I_LB)[l * 512 + d]; mx = fmaxf(mx, z[l]); }
        float s = 0.f;
#pragma unroll
        for (int l = 0; l < 4; ++l) { z[l] = expf(z[l] - mx); s += z[l]; }
        float cum = 0.f;
#pragma unroll
        for (int l = 0; l < 4; ++l) { const float lb = cum; cum += (l + 1 < 4) ? z[l + 1] / s : 0.f;
            float* o = c.LBT() + ((size_t)l * 512 + d) * 4; o[0] = lb; o[1] = logf(fmaxf(lb, 1e-30f)); o[2] = log1pf(-lb); o[3] = 0.f; }
    }
    grid.sync();

#pragma unroll 1
    for (int l = 0; l < DEPTH; ++l) {
        if (PHM & 2) {
            pg8::Gemm g{c.XB(), c.WIN(), MT, NIN, DM, DM, DM}; pg8::StaticOrder S; S.init(MT, NIN, OPQ_S(gridDim.x), OPQ_S(blockIdx.x));
            Epi1 E{c.AQ(), c.AK(), c.AV(), c.HQ(), c.HK(), c.HV(), c.HG(), c.G(), c.LOGF(), c.LBT() + (size_t)l * 2048, c.in(I_BG) + l * 2048,
                   c.out() + O_PK + (size_t)l * 65536, c.out() + O_PV + (size_t)l * 65536, c.out() + O_SK + (size_t)l * 2097152, c.out() + O_SV + (size_t)l * 2097152};
            pg8::gemm_phase<Epi1, pg8::StaticOrder, true, true>(lds, g, S, E);
        }
        grid.sync();
        for (int it = OPQ_S(blockIdx.x), G_ = OPQ_S(gridDim.x); it < 2048; it += G_) {
            if (it < 256) { if (PHM & 4) attn_prompt_unit(c, c.in(I_SINK) + l * 8, it, lds, OPAQUE_TID()); }
            else if (it < 512) { if (PHM & 8) attn_sample_unit(c, c.in(I_SINK) + l * 8, l, it - 256, lds, OPAQUE_TID()); }
            else if (it < 1536) { if (PHM & 16) hg_pass1_unit(c, it - 512, lds, OPAQUE_TID()); }
            else { if (PHM & 32) hg_sample_unit(c, c.in(I_NW) + l * 128, l, it - 1536, lds, OPAQUE_TID()); }
        }
        grid.sync();
        if (PHM & 64) hg_scan(c, c.out() + O_PS + (size_t)l * 262144, OPQ_S(blockIdx.x) * NTHREADS + OPAQUE_TID(), OPQ_S(gridDim.x) * NTHREADS);
        grid.sync();
        if (PHM & 128) for (int it = OPQ_S(blockIdx.x), G_ = OPQ_S(gridDim.x); it < 1024; it += G_) hg_pass3_unit(c, c.in(I_NW) + l * 128, it, lds, OPAQUE_TID());
        grid.sync();
        if (PHM & 256) {
            pg8::StaticOrder S; S.init(MP, DM, OPQ_S(gridDim.x), OPQ_S(blockIdx.x));
            { pg8::Gemm g{c.AH(), c.WUP(), MP, DM, 512, DM, DM}; EpiUp1 E{c.G(), c.Y()}; pg8::gemm_phase<EpiUp1, pg8::StaticOrder, true, true>(lds, g, S, E); }
            __syncthreads();
            { pg8::Gemm g{c.AH() + 512, c.WUP() + 512, MP, DM, 512, DM, DM}; EpiUp2 E{c.G(), c.Y(), c.MG()}; pg8::gemm_phase<EpiUp2, pg8::StaticOrder, true, true>(lds, g, S, E); }
            __syncthreads();
            { SEpiUp E{c.G(), c.MG()}; sample_gemm_tiles<1024, SEpiUp>(lds, c.AH() + (size_t)MP * 1024, 1024, c.WUP(), 1024, DM, E, OPQ_S(blockIdx.x), OPQ_S(gridDim.x), OPAQUE_TID()); }
        }
        grid.sync();
        if (PHM & 512) {
            pg8::Gemm g{c.MG(), c.WOUT(), MP, DM, DM, DM, DM}; pg8::StaticOrder S; S.init(MP, DM, OPQ_S(gridDim.x), OPQ_S(blockIdx.x));
            EpiRes E{c.X(), c.Y()}; pg8::gemm_phase<EpiRes, pg8::StaticOrder, true, true>(lds, g, S, E);
            __syncthreads();
            { SEpiRes E2{c.X(), c.Y()}; sample_gemm_tiles<1024, SEpiRes>(lds, c.MG() + (size_t)MP * 1024, 1024, c.WOUT(), 1024, DM, E2, OPQ_S(blockIdx.x), OPQ_S(gridDim.x), OPAQUE_TID()); }
        }
        grid.sync();
        if (PHM & 4096) for (int m = OPQ_S(gw), ngw_ = OPQ_S(ngw); m < MT; m += ngw_) ln_row(c.Y() + (size_t)m * DM, c.in(I_L1G) + l * DM, c.in(I_L1B) + l * DM, c.X() + (size_t)m * DM, c.XB() + (size_t)m * DM, nullptr, OPAQUE_TID() & 63, true);
        grid.sync();
        if (PHM & 1024) {
            pg8::Gemm g{c.XB(), c.WFF1(), MP, FF, DM, DM, DM}; pg8::StaticOrder S; S.init(MP, FF, OPQ_S(gridDim.x), OPQ_S(blockIdx.x));
            EpiRelu2 E{c.HB()}; pg8::gemm_phase<EpiRelu2, pg8::StaticOrder, true, true>(lds, g, S, E);
            __syncthreads();
            { SEpiRelu2 E2{c.HB()}; sample_gemm_tiles<1024, SEpiRelu2>(lds, c.XB() + (size_t)MP * 1024, 1024, c.WFF1(), 1024, FF, E2, OPQ_S(blockIdx.x), OPQ_S(gridDim.x), OPAQUE_TID()); }
        }
        grid.sync();
        if (PHM & 2048) {
            pg8::Gemm g{c.HB(), c.WFF2(), MP, DM, FF, FF, FF}; pg8::StaticOrder S; S.init(MP, DM, OPQ_S(gridDim.x), OPQ_S(blockIdx.x));
            EpiRes E{c.X(), c.Y()}; pg8::gemm_phase<EpiRes, pg8::StaticOrder, true, true>(lds, g, S, E);
            __syncthreads();
            { SEpiRes E2{c.X(), c.Y()}; sample_gemm_tiles<4096, SEpiRes>(lds, c.HB() + (size_t)MP * 4096, 4096, c.WFF2(), 4096, DM, E2, OPQ_S(blockIdx.x), OPQ_S(gridDim.x), OPAQUE_TID()); }
        }
        grid.sync();
        if (PHM & 4096) for (int m = OPQ_S(gw), ngw_ = OPQ_S(ngw); m < MT; m += ngw_) ln_row(c.Y() + (size_t)m * DM, c.in(I_L2G) + l * DM, c.in(I_L2B) + l * DM, c.X() + (size_t)m * DM, c.XB() + (size_t)m * DM,
                                                 l == DEPTH - 1 ? c.out() + O_Y + (size_t)m * DM : nullptr, OPAQUE_TID() & 63, true);
        if ((PHM & 1) && l + 1 < DEPTH) convert_layer(c, l + 1, lds, OPQ_S(gw), OPQ_S(ngw), wave, OPAQUE_TID() & 63);
        grid.sync();
    }
}

extern "C" void kernel_launch(void* const* d_in, const int* in_sizes, int n_in, void* d_out, int out_size, void* d_ws, size_t ws_size, hipStream_t stream) {
    static int grid = 0;
    if (grid == 0) {
        if (n_in != 19 || ws_size < WS_END) { fprintf(stderr, "kernel_launch: unexpected inputs (n_in %d, ws %zu, need %zu)\n", n_in, ws_size, (size_t)WS_END); grid = -1; return; }
        int dev = 0, cus = 0, per_cu = 0;
        hipGetDevice(&dev); hipDeviceGetAttribute(&cus, hipDeviceAttributeMultiprocessorCount, dev);
        hipFuncSetAttribute((const void*)hybrid_fwd, hipFuncAttributeMaxDynamicSharedMemorySize, LDS_BYTES);
        if (hipOccupancyMaxActiveBlocksPerMultiprocessor(&per_cu, (const void*)hybrid_fwd, NTHREADS, LDS_BYTES) != hipSuccess || per_cu < 1) { fprintf(stderr, "kernel_launch: occupancy query says %d\n", per_cu); per_cu = 1; }
        (void)hipGetLastError();
        grid = cus * 1;
        if (grid <= 0) grid = 256;
    }
    if (grid < 0) return;
    Params p{};
    p.x_prompt = (const float*)d_in[0]; p.x_sample = (const float*)d_in[1]; p.cache_k = (const float*)d_in[2]; p.cache_v = (const float*)d_in[3]; p.state = (const float*)d_in[4];
    p.w_in = (const float*)d_in[5]; p.b_gate = (const float*)d_in[6]; p.sink = (const float*)d_in[7]; p.lb_logits = (const float*)d_in[8]; p.norm_w = (const float*)d_in[9];
    p.w_upa = (const float*)d_in[10]; p.w_uph = (const float*)d_in[11]; p.w_out = (const float*)d_in[12]; p.ln1g = (const float*)d_in[13]; p.ln1b = (const float*)d_in[14];
    p.w_ff1 = (const float*)d_in[15]; p.w_ff2 = (const float*)d_in[16]; p.ln2g = (const float*)d_in[17]; p.ln2b = (const float*)d_in[18];
    p.out = (float*)d_out; p.ws = (unsigned char*)d_ws;
    void* args[] = {&p};
    hipError_t e = hipLaunchCooperativeKernel((const void*)hybrid_fwd, dim3(grid), dim3(NTHREADS), args, LDS_BYTES, stream);
    if (e != hipSuccess) fprintf(stderr, "kernel_launch: cooperative launch failed: %s (grid %d)\n", hipGetErrorString(e), grid);
}
```

```cpp
#include <hip/hip_runtime.h>
#include <hip/hip_cooperative_groups.h>
#include <cstdio>
#include <cstdint>
namespace cg = cooperative_groups;
namespace pg8 {
#define PG8_LAS __attribute__((address_space(3)))
typedef unsigned short bf16_t;
typedef short bf16x8 __attribute__((ext_vector_type(8)));
typedef float f32x4 __attribute__((ext_vector_type(4)));
typedef unsigned u32x4 __attribute__((ext_vector_type(4)));
constexpr int BM = 256, BK = 64, HALF = 128, HTB = HALF * BK * 2  , STAGE_BYTES = 8 * HTB, NXCD = 8, WGM = 8;

__host__ __device__ __forceinline__ int lds_byte(int r, int c) { const int st = (r >> 4) * 2 + (c >> 5), rr = r & 15, cc = c & 31, ob = rr * 64 + cc * 2; return st * 1024 + (ob ^ (((ob >> 9) & 1) << 5)); }
__host__ __device__ __forceinline__ void stage_rc(int b, int& R, int& C) { const int st = b / 1024, sb = b % 1024, swz = sb ^ (((sb >> 9) & 1) << 5); R = (st >> 1) * 16 + swz / 64; C = (st & 1) * 32 + (swz % 64) / 2; }
__host__ __device__ __forceinline__ int perm32(int rho) { const int n = rho >> 4, i = rho & 15; return 8 * (i >> 2) + 4 * n + (i & 3); }

struct Unit { int pm, pn; };
struct Gemm { const bf16_t* A; const bf16_t* Bt; int M, N, K, lda, ldb; };

struct StaticOrder {
    int nM, nN, nwg, G, c;
    __host__ __device__ void init(int M, int N, int G_, int c_) { nM = M / BM; nN = N / BM; nwg = nM * nN; G = G_; c = c_; }
    __host__ __device__ bool next(int i, Unit& u) const {
        const long L = (long)i * G + c; if (L >= nwg) return false;
        int wgid = (int)L; { const int q = nwg / NXCD, r = nwg % NXCD, xcd = wgid % NXCD, off = wgid / NXCD; wgid = (xcd < r ? xcd * (q + 1) : r * (q + 1) + (xcd - r) * q) + off; }
        const int nig = WGM * nN, gid = wgid / nig, fm = gid * WGM, gsz = (nM - fm) < WGM ? (nM - fm) : WGM;
        u.pm = fm + ((wgid % nig) % gsz); u.pn = (wgid % nig) / gsz; return true;
    }
    __device__ __forceinline__ void a_ready(const Unit&) const {}
    __device__ __forceinline__ void done(const Unit&) const {}
};

template <class Epi, class Sched, bool ALIGN_EPI = false, bool SP2 = false>
__device__ __forceinline__ void gemm_phase(PG8_LAS unsigned char* lds, const Gemm g, const Sched& S, const Epi& E) {
    int tid_op = threadIdx.x; asm volatile("" : "+v"(tid_op));
    const int tid = tid_op, wid = __builtin_amdgcn_readfirstlane(tid >> 6), lane = tid & 63, wr = wid >> 2, wc = wid & 3, fr = lane & 15, fq = lane >> 4;
    const int K = g.K, nt = K / BK;
    unsigned voffA[2], voffB[2];
#pragma unroll
    for (int i = 0; i < 2; ++i) { int R, C; stage_rc(tid * 16 + i * 8192, R, C); const int Rb = Epi::PERM ? ((R & ~31) + perm32(R & 31)) : R;
        voffA[i] = (unsigned)(R * g.lda + C) * 2u; voffB[i] = (unsigned)(Rb * g.ldb + C) * 2u; }
    const size_t kstep = (size_t)(BK * 2);
    const size_t hstepA = (size_t)HALF * g.lda * 2, hstepB = (size_t)HALF * g.ldb * 2;
    const size_t tstepA = 2 * hstepA, tstepB = 2 * hstepB;
    const unsigned ldsw = (unsigned)wid * 1024u;
    const int aoff = lds_byte(wr * 64 + fr, fq * 8), boff = lds_byte(wc * 32 + fr, fq * 8);
#define PG8_SA(b, h) (((b) * 2 + (h)) * HTB)
#define PG8_SB(b, h) ((4 + (b) * 2 + (h)) * HTB)
#define PG8_STAGE(bufoff, gbase, voff) do { _Pragma("unroll") for (int _i = 0; _i < 2; ++_i) \
        __builtin_amdgcn_global_load_lds((const unsigned*)((const char*)(gbase) + (voff)[_i]), (PG8_LAS unsigned*)(lds + (bufoff) + ldsw + _i * 8192), 16, 0, 0); } while (0)
#define PG8_LDA(dst, b, h) do { _Pragma("unroll") for (int m = 0; m < 4; ++m) _Pragma("unroll") for (int k = 0; k < 2; ++k) dst[m][k] = *(const PG8_LAS bf16x8*)(lds + PG8_SA(b, h) + aoff + m * 2048 + k * 1024); } while (0)
#define PG8_LDB(dst, b, h) do { _Pragma("unroll") for (int n = 0; n < 2; ++n) _Pragma("unroll") for (int k = 0; k < 2; ++k) dst[n][k] = *(const PG8_LAS bf16x8*)(lds + PG8_SB(b, h) + boff + n * 2048 + k * 1024); } while (0)
#define PG8_MMA(ai, bj, At, Bt) do { __builtin_amdgcn_s_setprio(1); _Pragma("unroll") for (int m = 0; m < 4; ++m) _Pragma("unroll") for (int n = 0; n < 2; ++n) _Pragma("unroll") for (int k = 0; k < 2; ++k) \
        acc[ai][bj][m][n] = __builtin_amdgcn_mfma_f32_16x16x32_bf16(Bt[n][k], At[m][k], acc[ai][bj][m][n], 0, 0, 0); __builtin_amdgcn_s_setprio(0); } while (0)
#define PG8_WAIT_V(n) asm volatile("s_waitcnt vmcnt(" #n ")" ::: "memory")
#define PG8_WAIT_L(n) asm volatile("s_waitcnt lgkmcnt(" #n ")" ::: "memory")
#define PG8_BAR __builtin_amdgcn_s_barrier()
#define PG8_SCHED __builtin_amdgcn_sched_barrier(0)
    Unit cur, nxt; int ui = 0;
    if (!S.next(0, cur)) return;
    f32x4 acc[2][2][4][2];
#pragma unroll
    for (int a = 0; a < 2; ++a)
#pragma unroll
        for (int b = 0; b < 2; ++b)
#pragma unroll
            for (int m = 0; m < 4; ++m)
#pragma unroll
                for (int n = 0; n < 2; ++n) acc[a][b][m][n] = (f32x4){0.f, 0.f, 0.f, 0.f};
    bf16x8 At[4][2], B0[2][2], B1[2][2];
    const char* cA = (const char*)g.A + (size_t)cur.pm * tstepA; const char* cB = (const char*)g.Bt + (size_t)cur.pn * tstepB;
    S.a_ready(cur);
    if constexpr (SP2) {
        PG8_STAGE(PG8_SB(0, 0), cB, voffB); PG8_STAGE(PG8_SB(0, 1), cB + hstepB, voffB); PG8_STAGE(PG8_SA(0, 0), cA, voffA); PG8_STAGE(PG8_SA(0, 1), cA + hstepA, voffA);
        if (wr == 1) PG8_BAR;
        PG8_WAIT_V(2); PG8_BAR;
        PG8_STAGE(PG8_SB(1, 0), cB + kstep, voffB); PG8_STAGE(PG8_SA(1, 0), cA + kstep, voffA); PG8_STAGE(PG8_SB(1, 1), cB + hstepB + kstep, voffB);
        PG8_WAIT_V(6); PG8_BAR;
    } else {
        PG8_STAGE(PG8_SB(0, 0), cB, voffB); PG8_STAGE(PG8_SA(0, 0), cA, voffA); PG8_STAGE(PG8_SB(0, 1), cB + hstepB, voffB); PG8_STAGE(PG8_SA(0, 1), cA + hstepA, voffA);
        if (wr == 1) PG8_BAR;
        PG8_WAIT_V(4); PG8_BAR;
        PG8_STAGE(PG8_SB(1, 0), cB + kstep, voffB); PG8_STAGE(PG8_SA(1, 0), cA + kstep, voffA); PG8_STAGE(PG8_SB(1, 1), cB + hstepB + kstep, voffB);
        PG8_WAIT_V(6); PG8_BAR;
    }
    for (;;) {
        const bool has_next = S.next(ui + 1, nxt);
        const char* nA = has_next ? (const char*)g.A + (size_t)nxt.pm * tstepA : cA; const char* nB = has_next ? (const char*)g.Bt + (size_t)nxt.pn * tstepB : cB;
        for (int t = 0; t < nt; t += 2) {
            const bool last = (t == nt - 2);
            const char* a1 = cA + (size_t)(t + 1) * kstep;
            const char* a2 = last ? nA : cA + (size_t)(t + 2) * kstep; const char* b2 = last ? nB : cB + (size_t)(t + 2) * kstep;
            const char* a3 = a2 + kstep; const char* b3 = b2 + kstep;
            if (last && has_next) S.a_ready(nxt);
            if constexpr (SP2) {
            PG8_LDB(B0, 0, 0); PG8_LDB(B1, 0, 1); PG8_SCHED; PG8_LDA(At, 0, 0); PG8_STAGE(PG8_SA(1, 1), a1 + hstepA, voffA);
            PG8_WAIT_V(8); PG8_WAIT_L(0); PG8_BAR; PG8_MMA(0, 0, At, B0); PG8_MMA(0, 1, At, B1); PG8_BAR; PG8_SCHED;
            PG8_LDA(At, 0, 1); PG8_STAGE(PG8_SB(0, 0), b2, voffB); PG8_STAGE(PG8_SB(0, 1), b2 + hstepB, voffB); PG8_STAGE(PG8_SA(0, 0), a2, voffA);
            PG8_WAIT_V(8); PG8_WAIT_L(0); PG8_BAR; PG8_MMA(1, 0, At, B0); PG8_MMA(1, 1, At, B1); PG8_BAR; PG8_SCHED;
            PG8_LDB(B0, 1, 0); PG8_LDB(B1, 1, 1); PG8_SCHED; PG8_LDA(At, 1, 0); PG8_STAGE(PG8_SA(0, 1), a2 + hstepA, voffA);
            PG8_WAIT_V(8); PG8_WAIT_L(0); PG8_BAR; PG8_MMA(0, 0, At, B0); PG8_MMA(0, 1, At, B1); PG8_BAR; PG8_SCHED;
            PG8_LDA(At, 1, 1); PG8_STAGE(PG8_SB(1, 0), b3, voffB); PG8_STAGE(PG8_SB(1, 1), b3 + hstepB, voffB); PG8_STAGE(PG8_SA(1, 0), a3, voffA);
            PG8_WAIT_V(8); PG8_WAIT_L(0); PG8_BAR; PG8_MMA(1, 0, At, B0); PG8_MMA(1, 1, At, B1); PG8_BAR; PG8_SCHED;
            } else {
            PG8_LDB(B0, 0, 0); PG8_SCHED; PG8_LDA(At, 0, 0); PG8_STAGE(PG8_SA(1, 1), a1 + hstepA, voffA);
            PG8_WAIT_L(8); PG8_BAR; PG8_WAIT_L(0); PG8_MMA(0, 0, At, B0); PG8_BAR; PG8_SCHED;
            PG8_LDB(B1, 0, 1); PG8_STAGE(PG8_SB(0, 0), b2, voffB);
            PG8_BAR; PG8_WAIT_L(0); PG8_MMA(0, 1, At, B1); PG8_BAR;
            PG8_LDA(At, 0, 1); PG8_STAGE(PG8_SA(0, 0), a2, voffA);
            PG8_BAR; PG8_WAIT_L(0); PG8_MMA(1, 0, At, B0); PG8_BAR; PG8_SCHED;
            PG8_STAGE(PG8_SB(0, 1), b2 + hstepB, voffB);
            PG8_WAIT_V(6); PG8_BAR; PG8_MMA(1, 1, At, B1); PG8_BAR;
            PG8_LDB(B0, 1, 0); PG8_SCHED; PG8_LDA(At, 1, 0); PG8_STAGE(PG8_SA(0, 1), a2 + hstepA, voffA);
            PG8_WAIT_L(8); PG8_BAR; PG8_WAIT_L(0); PG8_MMA(0, 0, At, B0); PG8_BAR; PG8_SCHED;
            PG8_LDB(B1, 1, 1); PG8_STAGE(PG8_SB(1, 0), b3, voffB);
            PG8_BAR; PG8_WAIT_L(0); PG8_MMA(0, 1, At, B1); PG8_BAR;
            PG8_LDA(At, 1, 1); PG8_STAGE(PG8_SA(1, 0), a3, voffA);
            PG8_BAR; PG8_WAIT_L(0); PG8_MMA(1, 0, At, B0); PG8_BAR; PG8_SCHED;
            PG8_STAGE(PG8_SB(1, 1), b3 + hstepB, voffB);
            PG8_WAIT_V(6); PG8_BAR; PG8_MMA(1, 1, At, B1); PG8_BAR;
            }
        }
        if constexpr (ALIGN_EPI) { if (wr == 0) PG8_BAR; }
        if constexpr (!Epi::AFTER_DRAIN) { E(acc, cur, wr, wc, fr, fq); S.done(cur); }
        if (!has_next) break;
#pragma unroll
        for (int a = 0; a < 2; ++a)
#pragma unroll
            for (int b = 0; b < 2; ++b)
#pragma unroll
                for (int m = 0; m < 4; ++m)
#pragma unroll
                    for (int n = 0; n < 2; ++n) acc[a][b][m][n] = (f32x4){0.f, 0.f, 0.f, 0.f};
        cur = nxt; cA = nA; cB = nB; ++ui;
        if constexpr (ALIGN_EPI) { if (wr == 1) PG8_BAR; }
    }
    PG8_WAIT_V(0);
    if constexpr (!ALIGN_EPI) { if (wr == 0) PG8_BAR; }
    PG8_BAR;
    if constexpr (Epi::AFTER_DRAIN) { E.fused(acc, cur, wr, wc, fr, fq, lds, wid, lane); S.done(cur); }
#undef PG8_SA
#undef PG8_SB
#undef PG8_STAGE
#undef PG8_LDA
#undef PG8_LDB
#undef PG8_MMA
#undef PG8_WAIT_V
#undef PG8_WAIT_L
#undef PG8_BAR
#undef PG8_SCHED
}
}


#define DI __device__ __forceinline__
#define LAS __attribute__((address_space(3)))
using pg8::bf16_t; using pg8::bf16x8; using pg8::f32x4; using pg8::u32x4;
typedef float f32x2 __attribute__((ext_vector_type(2)));
typedef unsigned u32x2 __attribute__((ext_vector_type(2)));
typedef __bf16 bf2_t __attribute__((ext_vector_type(2)));

constexpr int MP = 16384, MS = 512, MT = MP + MS;
constexpr int DM = 1024, NIN = 4864, FF = 4096, DEPTH = 4;
constexpr float ALPHA = 1.681792830507429f;
constexpr float LN_EPS = 1e-5f, RMS_EPS = 1e-6f;
constexpr int NWAVES = 8, NTHREADS = 512;
constexpr int LDS_BYTES = 147456;

constexpr size_t O_Y = 0, O_PK = (size_t)MT * DM, O_PV = O_PK + 262144, O_PS = O_PV + 262144, O_SK = O_PS + 1048576, O_SV = O_SK + 8388608, O_SS = O_SV + 8388608;

constexpr size_t MiB = 1u << 20;
constexpr size_t WS_LBT = 0;
constexpr size_t WS_WIN = 1 * MiB, WS_WUP = 11 * MiB, WS_WOUT = 13 * MiB, WS_WFF1 = 15 * MiB, WS_WFF2 = 23 * MiB;
constexpr size_t WS_X = 31 * MiB;
constexpr size_t WS_XB = 97 * MiB;
constexpr size_t WS_G = 130 * MiB;
constexpr size_t WS_AH = 196 * MiB;
constexpr size_t WS_R = 229 * MiB;
constexpr size_t WS_HB = WS_R;
constexpr size_t WS_Y = WS_R + 132 * MiB;
constexpr size_t WS_MG = WS_R;
constexpr size_t WS_LOGF = WS_R + 34 * MiB;
constexpr size_t WS_HQ = WS_R + 67 * MiB, WS_HK = WS_R + 84 * MiB, WS_HV = WS_R + 101 * MiB, WS_HG = WS_R + 118 * MiB;
constexpr size_t WS_DST = WS_R + 135 * MiB;
constexpr size_t WS_SB = WS_R + 199 * MiB;
constexpr size_t WS_AQ = 460 * MiB;
constexpr size_t WS_AK = 477 * MiB, WS_AV = 482 * MiB;
constexpr size_t WS_DEC = 487 * MiB;
constexpr size_t WS_END = 488 * MiB;

struct Params {
    const float *x_prompt, *x_sample, *cache_k, *cache_v, *state, *w_in, *b_gate, *sink, *lb_logits, *norm_w, *w_upa, *w_uph, *w_out, *ln1g, *ln1b, *w_ff1, *w_ff2, *ln2g, *ln2b;
    float* out; unsigned char* ws;
};

DI unsigned pk2(float lo, float hi) { f32x2 v = {lo, hi}; bf2_t b = __builtin_convertvector(v, bf2_t); return __builtin_bit_cast(unsigned, b); }
DI bf16_t f2bf(float x) { return (bf16_t)(pk2(x, 0.f) & 0xffffu); }
DI float bf2f(bf16_t h) { return __uint_as_float((unsigned)h << 16); }
DI float bflo(unsigned w) { return __uint_as_float(w << 16); }
DI float bfhi(unsigned w) { return __uint_as_float(w & 0xffff0000u); }
DI void st_bf16x8(bf16_t* p, f32x4 a, f32x4 b) { u32x4 w; w.x = pk2(a[0], a[1]); w.y = pk2(a[2], a[3]); w.z = pk2(b[0], b[1]); w.w = pk2(b[2], b[3]); *(u32x4*)p = w; }
DI void ld_bf16x8(const bf16_t* p, f32x4& a, f32x4& b) { const u32x4 w = *(const u32x4*)p; a = (f32x4){bflo(w.x), bfhi(w.x), bflo(w.y), bfhi(w.y)}; b = (f32x4){bflo(w.z), bfhi(w.z), bflo(w.w), bfhi(w.w)}; }
DI float sigm(float x) { return 1.f / (1.f + __expf(-x)); }
DI float silu(float x) { return x / (1.f + __expf(-x)); }
DI float wave_sum(float v) {
#pragma unroll
    for (int o = 1; o < 64; o <<= 1) v += __shfl_xor(v, o);
    return v;
}
#define MFMA16(a, b, c) __builtin_amdgcn_mfma_f32_16x16x32_bf16((a), (b), (c), 0, 0, 0)
#define LDS_WAIT() asm volatile("s_waitcnt lgkmcnt(0)" ::: "memory")

#define EPI_ARGS const f32x4 (&acc)[2][2][4][2], const pg8::Unit& u, int wr, int wc, int fr, int fq
#define EPI_OPAQUE asm volatile("" : "+v"(fr), "+v"(fq))
#define EPI_ROWS _Pragma("unroll") for (int ai = 0; ai < 2; ++ai) _Pragma("unroll") for (int m = 0; m < 4; ++m)
#define EPI_ROW (u.pm * 256 + ai * 128 + wr * 64 + m * 16 + fr)
#define EPI_COL(bj) (u.pn * 256 + (bj) * 128 + wc * 32 + 8 * fq)

struct Epi1 {
    static constexpr bool PERM = true, AFTER_DRAIN = false;
    bf16_t *AQ, *AK, *AV, *HQ, *HK, *HV, *HG, *G; float* LOGF; const float* LBT; const float* bgate; float *pk, *pv, *sk, *sv;
    template <int bj, int n> DI void hf_part(EPI_ARGS) const {
        const int d0 = EPI_COL(bj) - 1280 + 4 * n;
        f32x4 lb[4];
#pragma unroll
        for (int j = 0; j < 4; ++j) lb[j] = *(const f32x4*)(LBT + (size_t)(d0 + j) * 4);
        EPI_ROWS { const size_t row = EPI_ROW; f32x4 lo, ko;
#pragma unroll
            for (int j = 0; j < 4; ++j) { const float hf = acc[ai][bj][m][n][j]; const f32x4 L = lb[j];
                const float ls = fminf(hf, 0.f) - __logf(1.f + __expf(-fabsf(hf)));
                const float bb = L[2] + ls, mx = fmaxf(L[1], bb); lo[j] = mx + __logf(1.f + __expf(-fabsf(L[1] - bb)));
                ko[j] = (1.f - L[0]) / (1.f + __expf(hf)); }
            *(f32x4*)(LOGF + row * 512 + d0) = lo;
            u32x2 w; w.x = pk2(ko[0], ko[1]); w.y = pk2(ko[2], ko[3]); *(u32x2*)(HK + row * 512 + d0) = w;
            asm volatile("" ::: "memory"); }
    }
    DI void operator()(EPI_ARGS) const {
        EPI_OPAQUE;
        const int pn = u.pn;
        if (pn < 2) {
            EPI_ROWS { const size_t row = EPI_ROW;
#pragma unroll
                for (int bj = 0; bj < 2; ++bj) st_bf16x8(AQ + row * 512 + EPI_COL(bj), acc[ai][bj][m][0] * 0.125f, acc[ai][bj][m][1] * 0.125f); }
        } else if (pn == 2) {
            EPI_ROWS { const int row = EPI_ROW;
#pragma unroll
                for (int bj = 0; bj < 2; ++bj) { const int lc = wc * 32 + 8 * fq; const f32x4 v0 = acc[ai][bj][m][0], v1 = acc[ai][bj][m][1];
                    st_bf16x8((bj == 0 ? AK : AV) + (size_t)row * 128 + lc, v0, v1);
                    float* o = nullptr;
                    if (row < MP) { const int t = row & 4095, b = row >> 12; if (t >= 3968) o = (bj == 0 ? pk : pv) + (size_t)(b * 128 + t - 3968) * 128 + lc; }
                    else { const int r = row - MP; o = (bj == 0 ? sk : sv) + (size_t)((r >> 2) * 128 + 124 + (r & 3)) * 128 + lc; }
                    if (o) { *(f32x4*)o = v0; *(f32x4*)(o + 4) = v1; } } }
        } else if (pn < 5 || (pn >= 9 && pn < 11)) {
            bf16_t* dst = pn < 5 ? HQ : HG; const int cb = pn < 5 ? 768 : 2304;
            EPI_ROWS { const size_t row = EPI_ROW;
#pragma unroll
                for (int bj = 0; bj < 2; ++bj) { f32x4 v0 = acc[ai][bj][m][0], v1 = acc[ai][bj][m][1];
#pragma unroll
                    for (int j = 0; j < 4; ++j) { v0[j] = silu(v0[j]); v1[j] = silu(v1[j]); }
                    st_bf16x8(dst + row * 512 + (EPI_COL(bj) - cb), v0, v1); } }
        } else if (pn < 7) {
            hf_part<0, 0>(acc, u, wr, wc, fr, fq); hf_part<0, 1>(acc, u, wr, wc, fr, fq); hf_part<1, 0>(acc, u, wr, wc, fr, fq); hf_part<1, 1>(acc, u, wr, wc, fr, fq);
        } else if (pn < 9) {
            EPI_ROWS { const size_t row = EPI_ROW;
#pragma unroll
                for (int bj = 0; bj < 2; ++bj) st_bf16x8(HV + row * 512 + (EPI_COL(bj) - 1792), acc[ai][bj][m][0], acc[ai][bj][m][1]); }
        } else {
#pragma unroll
            for (int bj = 0; bj < 2; ++bj) { const int gc = EPI_COL(bj) - 2816; const f32x4 b0 = *(const f32x4*)(bgate + gc), b1 = *(const f32x4*)(bgate + gc + 4);
                EPI_ROWS { const size_t row = EPI_ROW; f32x4 v0 = acc[ai][bj][m][0] + b0, v1 = acc[ai][bj][m][1] + b1;
#pragma unroll
                    for (int j = 0; j < 4; ++j) { v0[j] = sigm(v0[j]); v1[j] = sigm(v1[j]); }
                    st_bf16x8(G + row * 2048 + gc, v0, v1); } }
        }
    }
};
struct EpiUp1 {
    static constexpr bool PERM = true, AFTER_DRAIN = false;
    const bf16_t* G; float* T;
    DI void operator()(EPI_ARGS) const {
        EPI_OPAQUE;
        EPI_ROWS { const size_t row = EPI_ROW;
#pragma unroll
            for (int bj = 0; bj < 2; ++bj) { const int c = EPI_COL(bj); f32x4 g0, g1; ld_bf16x8(G + row * 2048 + c, g0, g1);
                *(f32x4*)(T + row * 1024 + c) = g0 * acc[ai][bj][m][0]; *(f32x4*)(T + row * 1024 + c + 4) = g1 * acc[ai][bj][m][1]; } asm volatile("" ::: "memory"); }
    }
};
struct EpiUp2 {
    static constexpr bool PERM = true, AFTER_DRAIN = false;
    const bf16_t* G; const float* T; bf16_t* MG;
    DI void operator()(EPI_ARGS) const {
        EPI_OPAQUE;
        EPI_ROWS { const size_t row = EPI_ROW;
#pragma unroll
            for (int bj = 0; bj < 2; ++bj) { const int c = EPI_COL(bj); f32x4 g0, g1; ld_bf16x8(G + row * 2048 + 1024 + c, g0, g1);
                const f32x4 t0 = *(const f32x4*)(T + row * 1024 + c), t1 = *(const f32x4*)(T + row * 1024 + c + 4);
                st_bf16x8(MG + row * 1024 + c, t0 + g0 * acc[ai][bj][m][0], t1 + g1 * acc[ai][bj][m][1]); } asm volatile("" ::: "memory"); }
    }
};
struct EpiRes {
    static constexpr bool PERM = true, AFTER_DRAIN = false;
    const float* X; float* Y;
    DI void operator()(EPI_ARGS) const {
        EPI_OPAQUE;
        EPI_ROWS { const size_t row = EPI_ROW;
#pragma unroll
            for (int bj = 0; bj < 2; ++bj) { const int c = EPI_COL(bj);
                const f32x4 x0 = *(const f32x4*)(X + row * 1024 + c), x1 = *(const f32x4*)(X + row * 1024 + c + 4);
                *(f32x4*)(Y + row * 1024 + c) = x0 * ALPHA + acc[ai][bj][m][0]; *(f32x4*)(Y + row * 1024 + c + 4) = x1 * ALPHA + acc[ai][bj][m][1]; } asm volatile("" ::: "memory"); }
    }
};
struct EpiRelu2 {
    static constexpr bool PERM = true, AFTER_DRAIN = false;
    bf16_t* HB;
    DI void operator()(EPI_ARGS) const {
        EPI_OPAQUE;
        EPI_ROWS { const size_t row = EPI_ROW;
#pragma unroll
            for (int bj = 0; bj < 2; ++bj) { f32x4 v0 = acc[ai][bj][m][0], v1 = acc[ai][bj][m][1];
#pragma unroll
                for (int j = 0; j < 4; ++j) { const float a = fmaxf(v0[j], 0.f), b = fmaxf(v1[j], 0.f); v0[j] = a * a; v1[j] = b * b; }
                st_bf16x8(HB + row * 4096 + EPI_COL(bj), v0, v1); } asm volatile("" ::: "memory"); }
    }
};


template <int K, class Epi>
DI void sample_gemm_tiles(LAS unsigned char* lds, const bf16_t* A, int lda, const bf16_t* Bt, int ldb, int N, const Epi& E, int bid, int G, int tid) {
    const int wave = __builtin_amdgcn_readfirstlane(tid >> 6), lane = tid & 63, fr = lane & 15, fq = lane >> 4;
    constexpr int KSL = K / 8;
    const int ntiles = 16 * (N / 64), k0 = wave * KSL;
    LAS float* red = (LAS float*)lds;
    for (int t = bid; t < ntiles; t += G) {
        const int rb = t & 15, cb = t >> 4;
        const bf16_t* ap = A + (size_t)(rb * 32 + fr) * lda + k0 + 8 * fq;
        const bf16_t* bp = Bt + (size_t)(cb * 64 + fr) * ldb + k0 + 8 * fq;
        f32x4 acc[2][4];
#pragma unroll
        for (int m = 0; m < 2; ++m)
#pragma unroll
            for (int n = 0; n < 4; ++n) acc[m][n] = (f32x4){0.f, 0.f, 0.f, 0.f};
#pragma unroll 4
        for (int ks = 0; ks < KSL; ks += 32) {
            bf16x8 a[2], b[4];
#pragma unroll
            for (int m = 0; m < 2; ++m) a[m] = *(const bf16x8*)(ap + (size_t)m * 16 * lda + ks);
#pragma unroll
            for (int n = 0; n < 4; ++n) b[n] = *(const bf16x8*)(bp + (size_t)n * 16 * ldb + ks);
#pragma unroll
            for (int m = 0; m < 2; ++m)
#pragma unroll
                for (int n = 0; n < 4; ++n) acc[m][n] = MFMA16(b[n], a[m], acc[m][n]);
        }
        __syncthreads();
#pragma unroll
        for (int m = 0; m < 2; ++m)
#pragma unroll
            for (int n = 0; n < 4; ++n) *(LAS f32x4*)(red + (wave * 32 + 16 * m + fr) * 68 + 16 * n + 4 * fq) = acc[m][n];
        __syncthreads();
        const int row = tid >> 4, c4 = (tid & 15) * 4;
        f32x4 lo = {0.f, 0.f, 0.f, 0.f}, hi = {0.f, 0.f, 0.f, 0.f};
#pragma unroll
        for (int w = 0; w < 4; ++w) { lo += *(const LAS f32x4*)(red + (w * 32 + row) * 68 + c4); hi += *(const LAS f32x4*)(red + ((w + 4) * 32 + row) * 68 + c4); }
        E((size_t)(MP + rb * 32 + row), cb * 64 + c4, lo, hi);
    }
}
DI f32x4 ld_bf16x4(const bf16_t* p) { const u32x2 w = *(const u32x2*)p; return (f32x4){bflo(w.x), bfhi(w.x), bflo(w.y), bfhi(w.y)}; }
DI void st_bf16x4(bf16_t* p, f32x4 v) { u32x2 w; w.x = pk2(v[0], v[1]); w.y = pk2(v[2], v[3]); *(u32x2*)p = w; }
struct SEpiUp { const bf16_t* G; bf16_t* MG;
    DI void operator()(size_t row, int col, f32x4 lo, f32x4 hi) const { st_bf16x4(MG + row * 1024 + col, ld_bf16x4(G + row * 2048 + col) * lo + ld_bf16x4(G + row * 2048 + 1024 + col) * hi); } };
struct SEpiRes { const float* X; float* Y;
    DI void operator()(size_t row, int col, f32x4 lo, f32x4 hi) const { *(f32x4*)(Y + row * 1024 + col) = *(const f32x4*)(X + row * 1024 + col) * ALPHA + (lo + hi); } };
struct SEpiRelu2 { bf16_t* HB;
    DI void operator()(size_t row, int col, f32x4 lo, f32x4 hi) const { f32x4 v = lo + hi;
#pragma unroll
        for (int j = 0; j < 4; ++j) { const float a = fmaxf(v[j], 0.f); v[j] = a * a; }
        st_bf16x4(HB + row * 4096 + col, v); } };

constexpr int PARAM_LDS_OFF = 131072 + 1024;
struct Ctx {
    LAS unsigned char* lds0;
    DI unsigned long long ptr(int i) const { unsigned off = PARAM_LDS_OFF + 8 * i; asm volatile("" : "+s"(off));
        volatile LAS const unsigned* q = (volatile LAS const unsigned*)(lds0 + off);
        const unsigned lo = __builtin_amdgcn_readfirstlane(q[0]), hi = __builtin_amdgcn_readfirstlane(q[1]); return ((unsigned long long)hi << 32) | lo; }
    DI const float* in(int i) const { return (const float*)ptr(i); }
    DI float* out() const { return (float*)ptr(19); }
    DI unsigned char* ws() const { return (unsigned char*)ptr(20); }
#define CTXP(T, name, off) DI T* name() const { return (T*)(ws() + (off)); }
    CTXP(float, X, WS_X) CTXP(float, Y, WS_Y) CTXP(float, LOGF, WS_LOGF) CTXP(float, DST, WS_DST) CTXP(float, DEC, WS_DEC) CTXP(float, LBT, WS_LBT)
    CTXP(bf16_t, XB, WS_XB) CTXP(bf16_t, G, WS_G) CTXP(bf16_t, AH, WS_AH) CTXP(bf16_t, HB, WS_HB) CTXP(bf16_t, MG, WS_MG) CTXP(bf16_t, HQ, WS_HQ) CTXP(bf16_t, HK, WS_HK)
    CTXP(bf16_t, HV, WS_HV) CTXP(bf16_t, HG, WS_HG) CTXP(bf16_t, SB, WS_SB) CTXP(bf16_t, AQ, WS_AQ) CTXP(bf16_t, AK, WS_AK) CTXP(bf16_t, AV, WS_AV)
    CTXP(bf16_t, WIN, WS_WIN) CTXP(bf16_t, WUP, WS_WUP) CTXP(bf16_t, WOUT, WS_WOUT) CTXP(bf16_t, WFF1, WS_WFF1) CTXP(bf16_t, WFF2, WS_WFF2)
#undef CTXP
};
enum { I_XP = 0, I_XS, I_CK, I_CV, I_ST, I_WIN, I_BG, I_SINK, I_LB, I_NW, I_WUA, I_WUH, I_WOUT, I_L1G, I_L1B, I_WF1, I_WF2, I_L2G, I_L2B };

DI void transpose_item(const float* W, int N, bf16_t* WT, int ldt, int koff, LAS float* scr, int item, int lane) {
    const int nblk = N / 32, kb = item / nblk, nb = item % nblk, k0 = 64 * kb, n0 = 32 * nb;
#pragma unroll 8
    for (int i = 0; i < 32; ++i) { const int kk = 2 * i + (lane >> 5); scr[kk * 33 + (lane & 31)] = W[(size_t)(k0 + kk) * N + n0 + (lane & 31)]; }
    LDS_WAIT();
    const int c = lane & 7;
#pragma unroll
    for (int j = 0; j < 4; ++j) { const int n = (lane >> 3) + 8 * j; const LAS float* s = scr + (8 * c) * 33 + n;
        u32x4 o; o.x = pk2(s[0 * 33], s[1 * 33]); o.y = pk2(s[2 * 33], s[3 * 33]); o.z = pk2(s[4 * 33], s[5 * 33]); o.w = pk2(s[6 * 33], s[7 * 33]);
        *(u32x4*)(WT + (size_t)(n0 + n) * ldt + koff + k0 + 8 * c) = o; }
    LDS_WAIT();
}
DI void convert_layer(const Ctx& c, int l, LAS unsigned char* lds, int gw, int ngw, int wave, int lane) {
    LAS float* scr = (LAS float*)(lds + wave * 16384);
    constexpr int I_IN = (DM / 64) * (NIN / 32), I_UP = (512 / 64) * (DM / 32), I_OUT = (DM / 64) * (DM / 32), I_F1 = (DM / 64) * (FF / 32), I_F2 = (FF / 64) * (DM / 32);
    constexpr int NITEMS = I_IN + 2 * I_UP + I_OUT + I_F1 + I_F2;
    for (int it = gw; it < NITEMS; it += ngw) {
        int r = it;
        if (r < I_IN) { transpose_item(c.in(I_WIN) + (size_t)l * DM * NIN, NIN, c.WIN(), DM, 0, scr, r, lane); continue; } r -= I_IN;
        if (r < I_UP) { transpose_item(c.in(I_WUA) + (size_t)l * 512 * DM, DM, c.WUP(), DM, 0, scr, r, lane); continue; } r -= I_UP;
        if (r < I_UP) { transpose_item(c.in(I_WUH) + (size_t)l * 512 * DM, DM, c.WUP(), DM, 512, scr, r, lane); continue; } r -= I_UP;
        if (r < I_OUT) { transpose_item(c.in(I_WOUT) + (size_t)l * DM * DM, DM, c.WOUT(), DM, 0, scr, r, lane); continue; } r -= I_OUT;
        if (r < I_F1) { transpose_item(c.in(I_WF1) + (size_t)l * DM * FF, FF, c.WFF1(), DM, 0, scr, r, lane); continue; } r -= I_F1;
        transpose_item(c.in(I_WF2) + (size_t)l * FF * DM, DM, c.WFF2(), FF, 0, scr, r, lane);
    }
}
DI void ln_row(const float* src, const float* g, const float* b, float* xrow, bf16_t* xbrow, float* extra, int lane, bool do_ln) {
    const f32x4* xr = (const f32x4*)src + lane;
    f32x4 v[4]; float s = 0.f;
#pragma unroll
    for (int j = 0; j < 4; ++j) { v[j] = xr[64 * j]; s += (v[j][0] + v[j][1]) + (v[j][2] + v[j][3]); }
    if (do_ln) {
        const float mean = wave_sum(s) * (1.f / DM); float s2 = 0.f;
#pragma unroll
        for (int j = 0; j < 4; ++j) { v[j] = v[j] - mean; s2 += (v[j][0] * v[j][0] + v[j][1] * v[j][1]) + (v[j][2] * v[j][2] + v[j][3] * v[j][3]); }
        const float rstd = 1.f / sqrtf(wave_sum(s2) * (1.f / DM) + LN_EPS);
#pragma unroll
        for (int j = 0; j < 4; ++j) { const f32x4 gg = ((const f32x4*)g)[lane + 64 * j], bb = ((const f32x4*)b)[lane + 64 * j]; v[j] = v[j] * rstd * gg + bb; }
    }
#pragma unroll
    for (int j = 0; j < 4; ++j) {
        ((f32x4*)xrow)[lane + 64 * j] = v[j];
        if (extra) ((f32x4*)extra)[lane + 64 * j] = v[j];
        u32x2 w; w.x = pk2(v[j][0], v[j][1]); w.y = pk2(v[j][2], v[j][3]); ((u32x2*)xbrow)[lane + 64 * j] = w;
    }
}

DI void attn_prompt_unit(const Ctx& c, const float* sink_l, int u, LAS unsigned char* lds, int tid) {
    const int wave = tid >> 6, lane = tid & 63, fr = lane & 15, fq = lane >> 4;
    const int b = u >> 6, blk = (u >> 1) & 31, kvh = u & 1;
    LAS bf16_t* Ks = (LAS bf16_t*)lds;
    LAS bf16_t* VT = (LAS bf16_t*)(lds + 36864);
    const int rowq0 = b * 4096 + blk * 128;
    __syncthreads();
#pragma unroll
    for (int i = 0; i < 4; ++i) { const int ch = tid + 512 * i, key = ch >> 3, dp = ch & 7;
        int t = (blk - 1) * 128 + key; if (t < 0) t = key;
        const size_t grow = (size_t)(b * 4096 + t);
        const u32x4 kv = *(const u32x4*)(c.AK() + grow * 128 + kvh * 64 + dp * 8);
        const u32x4 vv = *(const u32x4*)(c.AV() + grow * 128 + kvh * 64 + dp * 8);
        *(LAS u32x4*)(Ks + key * 72 + dp * 8) = kv;
        LAS bf16_t* vt = VT + (dp * 8) * 264 + key;
        vt[0 * 264] = (bf16_t)(vv.x & 0xffffu); vt[1 * 264] = (bf16_t)(vv.x >> 16); vt[2 * 264] = (bf16_t)(vv.y & 0xffffu); vt[3 * 264] = (bf16_t)(vv.y >> 16);
        vt[4 * 264] = (bf16_t)(vv.z & 0xffffu); vt[5 * 264] = (bf16_t)(vv.z >> 16); vt[6 * 264] = (bf16_t)(vv.w & 0xffffu); vt[7 * 264] = (bf16_t)(vv.w >> 16); }
    __syncthreads();
    const int lo = wave & ~1, qi = 16 * wave + fr;
#pragma unroll 1
    for (int g = 0; g < 4; ++g) {
        const float sink = sink_l[kvh * 4 + g];
        const bf16_t* qp = c.AQ() + (size_t)(rowq0 + qi) * 512 + (kvh * 4 + g) * 64 + 8 * fq;
        const bf16x8 q0 = *(const bf16x8*)qp, q1 = *(const bf16x8*)(qp + 32);
        f32x4 s[10]; float mx = sink;
#pragma unroll
        for (int t = 0; t < 10; ++t) { const LAS bf16_t* kp = Ks + (16 * (lo + t) + fr) * 72 + 8 * fq;
            const bf16x8 k0 = *(const LAS bf16x8*)kp, k1 = *(const LAS bf16x8*)(kp + 32);
            f32x4 a = {0.f, 0.f, 0.f, 0.f}; a = MFMA16(k0, q0, a); a = MFMA16(k1, q1, a);
#pragma unroll
            for (int i = 0; i < 4; ++i) { const int kj = 16 * (lo + t) + 4 * fq + i; const bool valid = (kj >= qi) && (kj <= qi + 128) && (blk > 0 || kj >= 128);
                a[i] = valid ? a[i] : -1e30f; mx = fmaxf(mx, a[i]); }
            s[t] = a; }
        mx = fmaxf(mx, __shfl_xor(mx, 16)); mx = fmaxf(mx, __shfl_xor(mx, 32));
        float sum = 0.f;
#pragma unroll
        for (int t = 0; t < 10; ++t)
#pragma unroll
            for (int i = 0; i < 4; ++i) { const float pe = __expf(s[t][i] - mx); s[t][i] = pe; sum += pe; }
        sum += __shfl_xor(sum, 16); sum += __shfl_xor(sum, 32);
        sum += __expf(sink - mx);
        const float inv = 1.f / sum;
        f32x4 o[4];
#pragma unroll
        for (int dt = 0; dt < 4; ++dt) o[dt] = (f32x4){0.f, 0.f, 0.f, 0.f};
#pragma unroll
        for (int j = 0; j < 5; ++j) { u32x4 pw; pw.x = pk2(s[2 * j][0] * inv, s[2 * j][1] * inv); pw.y = pk2(s[2 * j][2] * inv, s[2 * j][3] * inv);
            pw.z = pk2(s[2 * j + 1][0] * inv, s[2 * j + 1][1] * inv); pw.w = pk2(s[2 * j + 1][2] * inv, s[2 * j + 1][3] * inv);
            const bf16x8 pf = __builtin_bit_cast(bf16x8, pw);
#pragma unroll
            for (int dt = 0; dt < 4; ++dt) { const LAS bf16_t* vp = VT + (16 * dt + fr) * 264 + 16 * lo + 32 * j + 4 * fq;
                const u32x2 va = *(const LAS u32x2*)vp, vb = *(const LAS u32x2*)(vp + 16); u32x4 vw; vw.x = va.x; vw.y = va.y; vw.z = vb.x; vw.w = vb.y;
                o[dt] = MFMA16(__builtin_bit_cast(bf16x8, vw), pf, o[dt]); } }
#pragma unroll
        for (int dt = 0; dt < 4; ++dt) { bf16_t* op = c.AH() + (size_t)(rowq0 + qi) * 1024 + (kvh * 4 + g) * 64 + 16 * dt + 4 * fq;
            u32x2 w; w.x = pk2(o[dt][0], o[dt][1]); w.y = pk2(o[dt][2], o[dt][3]); *(u32x2*)op = w; }
    }
}
DI void attn_sample_unit(const Ctx& c, const float* sink_l, int l, int u, LAS unsigned char* lds, int tid) {
    const int wave = tid >> 6, lane = tid & 63;
    const int bs = u >> 1, kvh = u & 1;
    LAS float* Ksm = (LAS float*)lds;
    LAS float* Vsm = Ksm + 132 * 65;
    LAS float* Qsm = Vsm + 132 * 64;
    LAS float* Psm = Qsm + 16 * 64;
    const float* ck = c.in(I_CK) + ((size_t)(l * 128 + bs) * 128) * 128 + kvh * 64;
    const float* cv = c.in(I_CV) + ((size_t)(l * 128 + bs) * 128) * 128 + kvh * 64;
    float* ok = c.out() + O_SK + ((size_t)(l * 128 + bs) * 128) * 128 + kvh * 64;
    float* ov = c.out() + O_SV + ((size_t)(l * 128 + bs) * 128) * 128 + kvh * 64;
    __syncthreads();
#pragma unroll
    for (int i = 0; i < 4; ++i) { const int idx = tid + 512 * i, j = idx >> 4, d4 = (idx & 15) * 4;
        const f32x4 kk = *(const f32x4*)(ck + (size_t)j * 128 + d4), vv = *(const f32x4*)(cv + (size_t)j * 128 + d4);
        Ksm[j * 65 + d4 + 0] = kk[0]; Ksm[j * 65 + d4 + 1] = kk[1]; Ksm[j * 65 + d4 + 2] = kk[2]; Ksm[j * 65 + d4 + 3] = kk[3];
        Vsm[j * 64 + d4 + 0] = vv[0]; Vsm[j * 64 + d4 + 1] = vv[1]; Vsm[j * 64 + d4 + 2] = vv[2]; Vsm[j * 64 + d4 + 3] = vv[3];
        if (j >= 4) { *(f32x4*)(ok + (size_t)(j - 4) * 128 + d4) = kk; *(f32x4*)(ov + (size_t)(j - 4) * 128 + d4) = vv; } }
    if (tid < 256) { const int t = tid >> 6, d = tid & 63; const size_t row = (size_t)(MP + bs * 4 + t);
        Ksm[(128 + t) * 65 + d] = bf2f(c.AK()[row * 128 + kvh * 64 + d]); Vsm[(128 + t) * 64 + d] = bf2f(c.AV()[row * 128 + kvh * 64 + d]); }
#pragma unroll
    for (int i = 0; i < 2; ++i) { const int idx = tid + 512 * i, r = idx >> 6, d = idx & 63, t = r >> 2, g = r & 3;
        Qsm[r * 64 + d] = bf2f(c.AQ()[(size_t)(MP + bs * 4 + t) * 512 + (kvh * 4 + g) * 64 + d]); }
    __syncthreads();
    for (int e = tid; e < 16 * 132; e += 512) { const int r = e / 132, j = e - r * 132, t = r >> 2;
        float a = 0.f;
#pragma unroll 8
        for (int d = 0; d < 64; ++d) a += Qsm[r * 64 + d] * Ksm[j * 65 + d];
        const bool valid = (j >= t) && (j <= 128 + t);
        Psm[r * 136 + j] = valid ? a : -1e30f; }
    __syncthreads();
#pragma unroll
    for (int rr = 0; rr < 2; ++rr) { const int r = 2 * wave + rr, g = r & 3; const float sink = sink_l[kvh * 4 + g];
        float v[3]; float mx = sink;
#pragma unroll
        for (int k = 0; k < 3; ++k) { const int j = lane + 64 * k; v[k] = (j < 132) ? Psm[r * 136 + j] : -1e30f; mx = fmaxf(mx, v[k]); }
#pragma unroll
        for (int o = 1; o < 64; o <<= 1) mx = fmaxf(mx, __shfl_xor(mx, o));
        float sum = 0.f;
#pragma unroll
        for (int k = 0; k < 3; ++k) { v[k] = __expf(v[k] - mx); sum += v[k]; }
        sum = wave_sum(sum) + __expf(sink - mx);
        const float inv = 1.f / sum;
#pragma unroll
        for (int k = 0; k < 3; ++k) { const int j = lane + 64 * k; if (j < 132) Psm[r * 136 + j] = v[k] * inv; } }
    __syncthreads();
#pragma unroll
    for (int i = 0; i < 2; ++i) { const int o = tid + 512 * i, r = o >> 6, d = o & 63;
        float a = 0.f;
        for (int j = 0; j < 132; ++j) a += Psm[r * 136 + j] * Vsm[j * 64 + d];
        c.AH()[(size_t)(MP + bs * 4 + (r >> 2)) * 1024 + (kvh * 4 + (r & 3)) * 64 + d] = f2bf(a); }
}
DI void hg_cumsum(const float* LOGF, int r0, int h, int d, int seg, LAS float* segtot, float (&bcs)[16], float& bend, float& bmid) {
    const float* lp = LOGF + (size_t)(r0 + 16 * seg) * 512 + h * 128 + d;
#pragma unroll
    for (int i = 0; i < 16; ++i) bcs[i] = lp[(size_t)i * 512];
    float run = 0.f;
#pragma unroll
    for (int i = 0; i < 16; ++i) { run += bcs[i]; bcs[i] = run; }
    segtot[seg * 128 + d] = run;
    __syncthreads();
    const float s0 = segtot[d], s1 = segtot[128 + d], s2 = segtot[256 + d], s3 = segtot[384 + d];
    const float off = seg == 0 ? 0.f : seg == 1 ? s0 : seg == 2 ? (s0 + s1) : (s0 + s1 + s2);
#pragma unroll
    for (int i = 0; i < 16; ++i) bcs[i] += off;
    bend = (s0 + s1) + (s2 + s3); bmid = s0 + s1;
}
DI void hg_pass1_unit(const Ctx& c, int u, LAS unsigned char* lds, int tid) {
    const int wave = tid >> 6, lane = tid & 63, fr = lane & 15, fq = lane >> 4;
    const int bh = u >> 6, ci = u & 63, bb = bh >> 2, h = bh & 3, r0 = bb * 4096 + 64 * ci;
    LAS bf16_t* KT = (LAS bf16_t*)lds;
    LAS bf16_t* VT = KT + 128 * 72;
    LAS float* segtot = (LAS float*)(lds + 2 * 128 * 72 * 2);
    const int d = tid & 127, seg = tid >> 7;
    __syncthreads();
    float bcs[16], bend, bmid; hg_cumsum(c.LOGF(), r0, h, d, seg, segtot, bcs, bend, bmid);
    const bf16_t* kp = c.HK() + (size_t)(r0 + 16 * seg) * 512 + h * 128 + d;
    const bf16_t* vp = c.HV() + (size_t)(r0 + 16 * seg) * 512 + h * 128 + d;
    unsigned kw[8], vw[8];
#pragma unroll
    for (int i = 0; i < 8; ++i) { const float k0 = bf2f(kp[(size_t)(2 * i) * 512]) * __expf(bend - bcs[2 * i]), k1 = bf2f(kp[(size_t)(2 * i + 1) * 512]) * __expf(bend - bcs[2 * i + 1]);
        kw[i] = pk2(k0, k1); vw[i] = (unsigned)vp[(size_t)(2 * i) * 512] | ((unsigned)vp[(size_t)(2 * i + 1) * 512] << 16); }
    *(LAS u32x4*)(KT + d * 72 + 16 * seg) = (u32x4){kw[0], kw[1], kw[2], kw[3]}; *(LAS u32x4*)(KT + d * 72 + 16 * seg + 8) = (u32x4){kw[4], kw[5], kw[6], kw[7]};
    *(LAS u32x4*)(VT + d * 72 + 16 * seg) = (u32x4){vw[0], vw[1], vw[2], vw[3]}; *(LAS u32x4*)(VT + d * 72 + 16 * seg + 8) = (u32x4){vw[4], vw[5], vw[6], vw[7]};
    if (seg == 0) c.DEC()[(size_t)u * 128 + d] = __expf(bend);
    __syncthreads();
    const LAS bf16_t* ap = VT + (16 * wave + fr) * 72 + 8 * fq;
    const bf16x8 a0 = *(const LAS bf16x8*)ap, a1 = *(const LAS bf16x8*)(ap + 32);
    float* dst = c.DST() + (size_t)u * 16384;
#pragma unroll
    for (int nt = 0; nt < 8; ++nt) { const LAS bf16_t* bp = KT + (16 * nt + fr) * 72 + 8 * fq;
        const bf16x8 b0 = *(const LAS bf16x8*)bp, b1 = *(const LAS bf16x8*)(bp + 32);
        f32x4 a = {0.f, 0.f, 0.f, 0.f}; a = MFMA16(a0, b0, a); a = MFMA16(a1, b1, a);
#pragma unroll
        for (int i = 0; i < 4; ++i) dst[(16 * wave + 4 * fq + i) * 128 + 16 * nt + fr] = a[i]; }
}
DI void hg_scan(const Ctx& c, float* ps_l, int gtid, int gthreads) {
    for (int it = gtid; it < 16 * 8192; it += gthreads) {
        const int bh = it >> 13, ed2 = it & 8191, e = ed2 >> 6, d = (ed2 & 63) * 2;
        f32x2 S = {0.f, 0.f};
        const float* dp = c.DST() + (size_t)(bh * 64) * 16384 + e * 128 + d;
        const float* qp = c.DEC() + (size_t)(bh * 64) * 128 + d;
        bf16_t* sp = c.SB() + (size_t)(bh * 64) * 16384 + e * 128 + d;
#pragma unroll 8
        for (int cc = 0; cc < 64; ++cc) { const f32x2 ds = *(const f32x2*)(dp + (size_t)cc * 16384), dc = *(const f32x2*)(qp + (size_t)cc * 128);
            *(unsigned*)(sp + (size_t)cc * 16384) = pk2(S[0], S[1]); S = dc * S + ds; }
        ps_l[(size_t)bh * 16384 + d * 128 + e] = S[0]; ps_l[(size_t)bh * 16384 + (d + 1) * 128 + e] = S[1];
    }
}
DI void hg_pass3_unit(const Ctx& c, const float* normw_l, int u, LAS unsigned char* lds, int tid) {
    const int wave = tid >> 6, lane = tid & 63, fr = lane & 15, fq = lane >> 4;
    const int bh = u >> 6, ci = u & 63, bb = bh >> 2, h = bh & 3, r0 = bb * 4096 + 64 * ci;
    LAS bf16_t* QS = (LAS bf16_t*)lds;
    LAS bf16_t* QM = QS + 64 * 136;
    LAS bf16_t* KM = QM + 64 * 136;
    LAS bf16_t* VT = KM + 64 * 136;
    LAS bf16_t* ATT = VT + 128 * 72;
    LAS float* segtot = (LAS float*)(ATT + 64 * 72);
    LAS float* ssq = segtot + 512;
    const int d = tid & 127, seg = tid >> 7;
    __syncthreads();
    float bcs[16], bend, bmid; hg_cumsum(c.LOGF(), r0, h, d, seg, segtot, bcs, bend, bmid);
    {
        const bf16_t* qp = c.HQ() + (size_t)(r0 + 16 * seg) * 512 + h * 128 + d;
        const bf16_t* kp = c.HK() + (size_t)(r0 + 16 * seg) * 512 + h * 128 + d;
        const bf16_t* vp = c.HV() + (size_t)(r0 + 16 * seg) * 512 + h * 128 + d;
        unsigned vw[8];
#pragma unroll
        for (int i = 0; i < 16; ++i) { const int t = 16 * seg + i; const float q = bf2f(qp[(size_t)i * 512]), k = bf2f(kp[(size_t)i * 512]);
            QS[t * 136 + d] = f2bf(q * __expf(bcs[i])); QM[t * 136 + d] = f2bf(q * __expf(bcs[i] - bmid)); KM[t * 136 + d] = f2bf(k * __expf(bmid - bcs[i])); }
#pragma unroll
        for (int i = 0; i < 8; ++i) vw[i] = (unsigned)vp[(size_t)(2 * i) * 512] | ((unsigned)vp[(size_t)(2 * i + 1) * 512] << 16);
        *(LAS u32x4*)(VT + d * 72 + 16 * seg) = (u32x4){vw[0], vw[1], vw[2], vw[3]}; *(LAS u32x4*)(VT + d * 72 + 16 * seg + 8) = (u32x4){vw[4], vw[5], vw[6], vw[7]};
    }
    __syncthreads();
    {
        const int mt = wave >> 1;
        bf16x8 af[4];
#pragma unroll
        for (int kk = 0; kk < 4; ++kk) af[kk] = *(const LAS bf16x8*)(QM + (16 * mt + fr) * 136 + 32 * kk + 8 * fq);
#pragma unroll
        for (int n2 = 0; n2 < 2; ++n2) { const int nt = (wave & 1) * 2 + n2; f32x4 a = {0.f, 0.f, 0.f, 0.f};
#pragma unroll
            for (int kk = 0; kk < 4; ++kk) a = MFMA16(af[kk], *(const LAS bf16x8*)(KM + (16 * nt + fr) * 136 + 32 * kk + 8 * fq), a);
#pragma unroll
            for (int i = 0; i < 4; ++i) { const int t = 16 * mt + 4 * fq + i, s = 16 * nt + fr; ATT[t * 72 + s] = f2bf(s <= t ? a[i] : 0.f); } }
    }
    __syncthreads();
    const int tt = wave & 3, eh = wave >> 2;
    bf16x8 qs[4], at[2];
#pragma unroll
    for (int kk = 0; kk < 4; ++kk) qs[kk] = *(const LAS bf16x8*)(QS + (16 * tt + fr) * 136 + 32 * kk + 8 * fq);
#pragma unroll
    for (int kk = 0; kk < 2; ++kk) at[kk] = *(const LAS bf16x8*)(ATT + (16 * tt + fr) * 72 + 32 * kk + 8 * fq);
    f32x4 o[4]; float ss = 0.f;
    const bf16_t* sb = c.SB() + (size_t)u * 16384;
#pragma unroll
    for (int j = 0; j < 4; ++j) { const int et = 4 * eh + j; f32x4 a = {0.f, 0.f, 0.f, 0.f};
#pragma unroll
        for (int kk = 0; kk < 4; ++kk) a = MFMA16(*(const bf16x8*)(sb + (16 * et + fr) * 128 + 32 * kk + 8 * fq), qs[kk], a);
#pragma unroll
        for (int kk = 0; kk < 2; ++kk) a = MFMA16(*(const LAS bf16x8*)(VT + (16 * et + fr) * 72 + 32 * kk + 8 * fq), at[kk], a);
        o[j] = a; ss += (a[0] * a[0] + a[1] * a[1]) + (a[2] * a[2] + a[3] * a[3]); }
    ss += __shfl_xor(ss, 16); ss += __shfl_xor(ss, 32);
    if (fq == 0) ssq[eh * 64 + 16 * tt + fr] = ss;
    __syncthreads();
    const float rinv = rsqrtf((ssq[16 * tt + fr] + ssq[64 + 16 * tt + fr]) * (1.f / 128.f) + RMS_EPS);
    const size_t row = (size_t)(r0 + 16 * tt + fr);
#pragma unroll
    for (int j = 0; j < 4; ++j) { const int e0 = 16 * (4 * eh + j) + 4 * fq;
        const u32x2 hw = *(const u32x2*)(c.HG() + row * 512 + h * 128 + e0); const f32x4 nw = *(const f32x4*)(normw_l + e0);
        const float r0_ = o[j][0] * rinv * nw[0] * bflo(hw.x), r1_ = o[j][1] * rinv * nw[1] * bfhi(hw.x), r2_ = o[j][2] * rinv * nw[2] * bflo(hw.y), r3_ = o[j][3] * rinv * nw[3] * bfhi(hw.y);
        u32x2 w; w.x = pk2(r0_, r1_); w.y = pk2(r2_, r3_); *(u32x2*)(c.AH() + row * 1024 + 512 + h * 128 + e0) = w; }
}
DI void hg_sample_unit(const Ctx& c, const float* normw_l, int l, int u, LAS unsigned char* lds, int tid) {
    const int wave = tid >> 6, lane = tid & 63;
    const int bs = u >> 2, h = u & 3;
    LAS float* red = (LAS float*)lds;
    LAS float* ssq = red + 4 * 16 * 128;
    const int dg = tid >> 5, e4 = (tid & 31) * 4;
    const float* sp = c.in(I_ST) + ((size_t)((l * 128 + bs) * 4 + h)) * 16384;
    float* so = c.out() + O_SS + ((size_t)((l * 128 + bs) * 4 + h)) * 16384;
    __syncthreads();
    f32x4 S[8];
#pragma unroll
    for (int dd = 0; dd < 8; ++dd) S[dd] = *(const f32x4*)(sp + (dg * 8 + dd) * 128 + e4);
#pragma unroll
    for (int t = 0; t < 4; ++t) { const size_t row = (size_t)(MP + bs * 4 + t);
        const u32x2 vw = *(const u32x2*)(c.HV() + row * 512 + h * 128 + e4); const f32x4 v = {bflo(vw.x), bfhi(vw.x), bflo(vw.y), bfhi(vw.y)};
        f32x4 po = {0.f, 0.f, 0.f, 0.f};
#pragma unroll
        for (int dd = 0; dd < 8; ++dd) { const size_t ix = row * 512 + h * 128 + dg * 8 + dd;
            const float f = __expf(c.LOGF()[ix]), k = bf2f(c.HK()[ix]), q = bf2f(c.HQ()[ix]);
            S[dd] = S[dd] * f + v * k; po = po + S[dd] * q; }
        *(LAS f32x4*)(red + (t * 16 + dg) * 128 + e4) = po; }
#pragma unroll
    for (int dd = 0; dd < 8; ++dd) *(f32x4*)(so + (dg * 8 + dd) * 128 + e4) = S[dd];
    __syncthreads();
    const int t = tid >> 7, e = tid & 127;
    float o = 0.f;
#pragma unroll
    for (int g = 0; g < 16; ++g) o += red[(t * 16 + g) * 128 + e];
    const float ss = wave_sum(o * o);
    if (lane == 0) ssq[wave] = ss;
    __syncthreads();
    const float rinv = rsqrtf((ssq[wave & ~1] + ssq[(wave & ~1) + 1]) * (1.f / 128.f) + RMS_EPS);
    const size_t row = (size_t)(MP + bs * 4 + t);
    c.AH()[row * 1024 + 512 + h * 128 + e] = f2bf(o * rinv * normw_l[e] * bf2f(c.HG()[row * 512 + h * 128 + e]));
}

#define XB_TMO      128
#define XB_XCNT(j)  (256  + 64 * (j))
#define XB_XSUB(j)  (1280 + 64 * (j))
#define XB_XGEN(j)  (2304 + 64 * (j))
#define XB_TOP      3328
#define XB_TOPGEN   3392
#define XCD_BAR_WORDS 3456
#define XB_SPIN_CAP (1u << 18)

__device__ __forceinline__ unsigned xb_ld(unsigned* p)              { return __hip_atomic_load(p, __ATOMIC_RELAXED, __HIP_MEMORY_SCOPE_AGENT); }
__device__ __forceinline__ unsigned xb_add(unsigned* p, unsigned v) { return __hip_atomic_fetch_add(p, v, __ATOMIC_RELAXED, __HIP_MEMORY_SCOPE_AGENT); }
__device__ __forceinline__ unsigned xb_xcc_id() { return (unsigned)__builtin_amdgcn_s_getreg((3 << 11) | 20) & 0xFu; }
#define XB_SPIN(cond, bar) do { unsigned _sp = 0; while (cond) { __builtin_amdgcn_s_sleep(1); \
    if ((++_sp & 255u) == 0u) { if (xb_ld(&(bar)[XB_TMO])) break; if (_sp > XB_SPIN_CAP) { atomicAdd(&(bar)[XB_TMO], 1u); break; } } } } while (0)

struct XcdBarrier {
    unsigned* bar; unsigned x;
    volatile LAS unsigned* st;
};

__device__ __forceinline__ XcdBarrier xcd_barrier_post(unsigned* bar, volatile LAS unsigned* st) {
    XcdBarrier b; b.bar = bar; b.x = xb_xcc_id(); b.st = st;
    if (threadIdx.x == 0) (void)xb_add(&bar[XB_XCNT(b.x)], 1u);
    return b;
}
__device__ __forceinline__ void xcd_barrier_complete(unsigned* bar, unsigned x, unsigned& nloc, unsigned& nx) {
    const unsigned G = gridDim.x * gridDim.y * gridDim.z;
    unsigned sum, cnt, mine, sp = 0u;
    for (;;) {
        sum = 0u; cnt = 0u; mine = 0u;
#pragma unroll
        for (unsigned j = 0; j < 16; ++j) { const unsigned c = xb_ld(&bar[XB_XCNT(j)]); sum += c; cnt += (c > 0u) ? 1u : 0u; mine = (j == x) ? c : mine; }
        if (sum == G) break;
        __builtin_amdgcn_s_sleep(1);
        if ((++sp & 255u) == 0u) { if (xb_ld(&bar[XB_TMO])) break; if (sp > XB_SPIN_CAP) { atomicAdd(&bar[XB_TMO], 1u); break; } }
    }
    nloc = mine > 0u ? mine : 1u; nx = cnt > 0u ? cnt : 1u;
}

__device__ __forceinline__ void xcd_barrier(const XcdBarrier& b) {
    asm volatile("s_waitcnt vmcnt(0)" ::: "memory");
    __syncthreads();
    if (threadIdx.x == 0) {
        unsigned* bar = b.bar;
        __builtin_amdgcn_s_waitcnt(0);
        unsigned nloc = b.st[0], nx = b.st[1];
        if (nloc == 0u) { xcd_barrier_complete(bar, b.x, nloc, nx); b.st[0] = nloc; b.st[1] = nx; }
        const unsigned old = xb_add(&bar[XB_XSUB(b.x)], 1u);
        const unsigned gen = old / nloc;
        if (old + 1u == (gen + 1u) * nloc) {
            __builtin_amdgcn_fence(__ATOMIC_RELEASE, "agent");
            asm volatile("s_waitcnt vmcnt(0)" ::: "memory");
            const unsigned og = xb_add(&bar[XB_TOP], 1u);
            const unsigned tg = og / nx;
            if (og + 1u == (tg + 1u) * nx) xb_add(&bar[XB_TOPGEN], 1u);
            else XB_SPIN(xb_ld(&bar[XB_TOPGEN]) == tg, bar);
            __builtin_amdgcn_fence(__ATOMIC_ACQUIRE, "agent");
            xb_add(&bar[XB_XGEN(b.x)], 1u);
            asm volatile("s_waitcnt vmcnt(0)" ::: "memory");
        } else {
            XB_SPIN(xb_ld(&bar[XB_XGEN(b.x)]) == gen, bar);
            __builtin_amdgcn_fence(__ATOMIC_ACQUIRE, "agent");
            asm volatile("s_waitcnt vmcnt(0)" ::: "memory");
        }
    }
    __syncthreads();
}

constexpr size_t WS_BAR = 65536;
constexpr int BAR_LDS_OFF = 131072 + 512;

#define OPQ_S(x) ({ int s_ = (x); asm volatile("" : "+s"(s_)); s_; })
#define OPAQUE_TID() ({ int t_ = threadIdx.x; asm volatile("" : "+v"(t_)); t_; })
#ifndef PHM
#define PHM 0xFFFFF
#endif
__global__ void __launch_bounds__(NTHREADS, 2) hybrid_fwd(Params p) {
    extern __shared__ __attribute__((aligned(16))) unsigned char lds_raw[];
    LAS unsigned char* lds = (LAS unsigned char*)lds_raw;
    cg::grid_group grid = cg::this_grid();
    const int tid = threadIdx.x, lane = tid & 63, wave = __builtin_amdgcn_readfirstlane(tid >> 6);
    const int G = gridDim.x, bid = blockIdx.x;
    const int gw = bid * NWAVES + wave, ngw = G * NWAVES;
    Ctx c; c.lds0 = lds;
    if (tid == 0) { LAS unsigned long long* w = (LAS unsigned long long*)(lds + PARAM_LDS_OFF);
        w[0] = (unsigned long long)p.x_prompt; w[1] = (unsigned long long)p.x_sample; w[2] = (unsigned long long)p.cache_k; w[3] = (unsigned long long)p.cache_v; w[4] = (unsigned long long)p.state;
        w[5] = (unsigned long long)p.w_in; w[6] = (unsigned long long)p.b_gate; w[7] = (unsigned long long)p.sink; w[8] = (unsigned long long)p.lb_logits; w[9] = (unsigned long long)p.norm_w;
        w[10] = (unsigned long long)p.w_upa; w[11] = (unsigned long long)p.w_uph; w[12] = (unsigned long long)p.w_out; w[13] = (unsigned long long)p.ln1g; w[14] = (unsigned long long)p.ln1b;
        w[15] = (unsigned long long)p.w_ff1; w[16] = (unsigned long long)p.w_ff2; w[17] = (unsigned long long)p.ln2g; w[18] = (unsigned long long)p.ln2b; w[19] = (unsigned long long)p.out; w[20] = (unsigned long long)p.ws; }
    if (tid == 0) { ((volatile LAS unsigned*)(lds + BAR_LDS_OFF))[0] = 0u; ((volatile LAS unsigned*)(lds + BAR_LDS_OFF))[1] = 0u; }
    __syncthreads();

    if (bid == 0) { unsigned* bw = (unsigned*)(c.ws() + WS_BAR); for (int i = tid; i < XCD_BAR_WORDS; i += NTHREADS) bw[i] = 0u; }
    if (PHM & 1) convert_layer(c, 0, lds, gw, ngw, wave, lane);
    if (PHM & 1) for (int m = gw; m < MT; m += ngw) {
        const float* src = m < MP ? c.in(I_XP) + (size_t)m * DM : c.in(I_XS) + (size_t)(m - MP) * DM;
        ln_row(src, nullptr, nullptr, c.X() + (size_t)m * DM, c.XB() + (size_t)m * DM, nullptr, lane, false);
    }
    if (bid == 0) {
        const int d = tid;
        float z[4], mx = -3.0e38f;
#pragma unroll
        for (int l = 0; l < 4; ++l) { z[l] = c.in(I_LB)[l * 512 + d]; mx = fmaxf(mx, z[l]); }
        float s = 0.f;
#pragma unroll
        for (int l = 0; l < 4; ++l) { z[l] = expf(z[l] - mx); s += z[l]; }
        float cum = 0.f;
#pragma unroll
        for (int l = 0; l < 4; ++l) { const float lb = cum; cum += (l + 1 < 4) ? z[l + 1] / s : 0.f;
            float* o = c.LBT() + ((size_t)l * 512 + d) * 4; o[0] = lb; o[1] = logf(fmaxf(lb, 1e-30f)); o[2] = log1pf(-lb); o[3] = 0.f; }
    }
    grid.sync();
    (void)xcd_barrier_post((unsigned*)(c.ws() + WS_BAR), (volatile LAS unsigned*)(lds + BAR_LDS_OFF));
#define XBAR() do { XcdBarrier xb_; xb_.bar = (unsigned*)(c.ws() + WS_BAR); xb_.x = xb_xcc_id(); xb_.st = (volatile LAS unsigned*)(lds + BAR_LDS_OFF); xcd_barrier(xb_); } while (0)

#pragma unroll 1
    for (int l = 0; l < DEPTH; ++l) {
        if (PHM & 2) {
            pg8::Gemm g{c.XB(), c.WIN(), MT, NIN, DM, DM, DM}; pg8::StaticOrder S; S.init(MT, NIN, OPQ_S(gridDim.x), OPQ_S(blockIdx.x));
            Epi1 E{c.AQ(), c.AK(), c.AV(), c.HQ(), c.HK(), c.HV(), c.HG(), c.G(), c.LOGF(), c.LBT() + (size_t)l * 2048, c.in(I_BG) + l * 2048,
                   c.out() + O_PK + (size_t)l * 65536, c.out() + O_PV + (size_t)l * 65536, c.out() + O_SK + (size_t)l * 2097152, c.out() + O_SV + (size_t)l * 2097152};
            pg8::gemm_phase<Epi1, pg8::StaticOrder, true, true>(lds, g, S, E);
        }
        XBAR();
        for (int it = OPQ_S(blockIdx.x), G_ = OPQ_S(gridDim.x); it < 2048; it += G_) {
            if (it < 256) { if (PHM & 4) attn_prompt_unit(c, c.in(I_SINK) + l * 8, it, lds, OPAQUE_TID()); }
            else if (it < 512) { if (PHM & 8) attn_sample_unit(c, c.in(I_SINK) + l * 8, l, it - 256, lds, OPAQUE_TID()); }
            else if (it < 1536) { if (PHM & 16) hg_pass1_unit(c, it - 512, lds, OPAQUE_TID()); }
            else { if (PHM & 32) hg_sample_unit(c, c.in(I_NW) + l * 128, l, it - 1536, lds, OPAQUE_TID()); }
        }
        XBAR();
        if (PHM & 64) hg_scan(c, c.out() + O_PS + (size_t)l * 262144, OPQ_S(blockIdx.x) * NTHREADS + OPAQUE_TID(), OPQ_S(gridDim.x) * NTHREADS);
        XBAR();
        if (PHM & 128) for (int it = OPQ_S(blockIdx.x), G_ = OPQ_S(gridDim.x); it < 1024; it += G_) hg_pass3_unit(c, c.in(I_NW) + l * 128, it, lds, OPAQUE_TID());
        XBAR();
        if (PHM & 256) {
            pg8::StaticOrder S; S.init(MP, DM, OPQ_S(gridDim.x), OPQ_S(blockIdx.x));
            { pg8::Gemm g{c.AH(), c.WUP(), MP, DM, 512, DM, DM}; EpiUp1 E{c.G(), c.Y()}; pg8::gemm_phase<EpiUp1, pg8::StaticOrder, true, true>(lds, g, S, E); }
            __syncthreads();
            { pg8::Gemm g{c.AH() + 512, c.WUP() + 512, MP, DM, 512, DM, DM}; EpiUp2 E{c.G(), c.Y(), c.MG()}; pg8::gemm_phase<EpiUp2, pg8::StaticOrder, true, true>(lds, g, S, E); }
            __syncthreads();
            { SEpiUp E{c.G(), c.MG()}; sample_gemm_tiles<1024, SEpiUp>(lds, c.AH() + (size_t)MP * 1024, 1024, c.WUP(), 1024, DM, E, OPQ_S(blockIdx.x), OPQ_S(gridDim.x), OPAQUE_TID()); }
        }
        XBAR();
        if (PHM & 512) {
            pg8::Gemm g{c.MG(), c.WOUT(), MP, DM, DM, DM, DM}; pg8::StaticOrder S; S.init(MP, DM, OPQ_S(gridDim.x), OPQ_S(blockIdx.x));
            EpiRes E{c.X(), c.Y()}; pg8::gemm_phase<EpiRes, pg8::StaticOrder, true, true>(lds, g, S, E);
            __syncthreads();
            { SEpiRes E2{c.X(), c.Y()}; sample_gemm_tiles<1024, SEpiRes>(lds, c.MG() + (size_t)MP * 1024, 1024, c.WOUT(), 1024, DM, E2, OPQ_S(blockIdx.x), OPQ_S(gridDim.x), OPAQUE_TID()); }
        }
        XBAR();
        if (PHM & 4096) for (int m = OPQ_S(gw), ngw_ = OPQ_S(ngw); m < MT; m += ngw_) ln_row(c.Y() + (size_t)m * DM, c.in(I_L1G) + l * DM, c.in(I_L1B) + l * DM, c.X() + (size_t)m * DM, c.XB() + (size_t)m * DM, nullptr, OPAQUE_TID() & 63, true);
        XBAR();
        if (PHM & 1024) {
            pg8::Gemm g{c.XB(), c.WFF1(), MP, FF, DM, DM, DM}; pg8::StaticOrder S; S.init(MP, FF, OPQ_S(gridDim.x), OPQ_S(blockIdx.x));
            EpiRelu2 E{c.HB()}; pg8::gemm_phase<EpiRelu2, pg8::StaticOrder, true, true>(lds, g, S, E);
            __syncthreads();
            { SEpiRelu2 E2{c.HB()}; sample_gemm_tiles<1024, SEpiRelu2>(lds, c.XB() + (size_t)MP * 1024, 1024, c.WFF1(), 1024, FF, E2, OPQ_S(blockIdx.x), OPQ_S(gridDim.x), OPAQUE_TID()); }
        }
        XBAR();
        if (PHM & 2048) {
            pg8::Gemm g{c.HB(), c.WFF2(), MP, DM, FF, FF, FF}; pg8::StaticOrder S; S.init(MP, DM, OPQ_S(gridDim.x), OPQ_S(blockIdx.x));
            EpiRes E{c.X(), c.Y()}; pg8::gemm_phase<EpiRes, pg8::StaticOrder, true, true>(lds, g, S, E);
            __syncthreads();
            { SEpiRes E2{c.X(), c.Y()}; sample_gemm_tiles<4096, SEpiRes>(lds, c.HB() + (size_t)MP * 4096, 4096, c.WFF2(), 4096, DM, E2, OPQ_S(blockIdx.x), OPQ_S(gridDim.x), OPAQUE_TID()); }
        }
        XBAR();
        if (PHM & 4096) for (int m = OPQ_S(gw), ngw_ = OPQ_S(ngw); m < MT; m += ngw_) ln_row(c.Y() + (size_t)m * DM, c.in(I_L2G) + l * DM, c.in(I_L2B) + l * DM, c.X() + (size_t)m * DM, c.XB() + (size_t)m * DM,
                                                 l == DEPTH - 1 ? c.out() + O_Y + (size_t)m * DM : nullptr, OPAQUE_TID() & 63, true);
        if ((PHM & 1) && l + 1 < DEPTH) convert_layer(c, l + 1, lds, OPQ_S(gw), OPQ_S(ngw), wave, OPAQUE_TID() & 63);
        XBAR();
    }
}

extern "C" void kernel_launch(void* const* d_in, const int* in_sizes, int n_in, void* d_out, int out_size, void* d_ws, size_t ws_size, hipStream_t stream) {
    static int grid = 0;
    if (grid == 0) {
        if (n_in != 19 || ws_size < WS_END) { fprintf(stderr, "kernel_launch: unexpected inputs (n_in %d, ws %zu, need %zu)\n", n_in, ws_size, (size_t)WS_END); grid = -1; return; }
        int dev = 0, cus = 0, per_cu = 0;
        hipGetDevice(&dev); hipDeviceGetAttribute(&cus, hipDeviceAttributeMultiprocessorCount, dev);
        hipFuncSetAttribute((const void*)hybrid_fwd, hipFuncAttributeMaxDynamicSharedMemorySize, LDS_BYTES);
        if (hipOccupancyMaxActiveBlocksPerMultiprocessor(&per_cu, (const void*)hybrid_fwd, NTHREADS, LDS_BYTES) != hipSuccess || per_cu < 1) { fprintf(stderr, "kernel_launch: occupancy query says %d\n", per_cu); per_cu = 1; }
        (void)hipGetLastError();
        grid = cus * 1;
        if (grid <= 0) grid = 256;
    }
    if (grid < 0) return;
    Params p{};
    p.x_prompt = (const float*)d_in[0]; p.x_sample = (const float*)d_in[1]; p.cache_k = (const float*)d_in[2]; p.cache_v = (const float*)d_in[3]; p.state = (const float*)d_in[4];
    p.w_in = (const float*)d_in[5]; p.b_gate = (const float*)d_in[6]; p.sink = (const float*)d_in[7]; p.lb_logits = (const float*)d_in[8]; p.norm_w = (const float*)d_in[9];
    p.w_upa = (const float*)d_in[10]; p.w_uph = (const float*)d_in[11]; p.w_out = (const float*)d_in[12]; p.ln1g = (const float*)d_in[13]; p.ln1b = (const float*)d_in[14];
    p.w_ff1 = (const float*)d_in[15]; p.w_ff2 = (const float*)d_in[16]; p.ln2g = (const float*)d_in[17]; p.ln2b = (const float*)d_in[18];
    p.out = (float*)d_out; p.ws = (unsigned char*)d_ws;
    void* args[] = {&p};
    hipError_t e = hipLaunchCooperativeKernel((const void*)hybrid_fwd, dim3(grid), dim3(NTHREADS), args, LDS_BYTES, stream);
    if (e != hipSuccess) fprintf(stderr, "kernel_launch: cooperative launch failed: %s (grid %d)\n", hipGetErrorString(e), grid);
}
```
